# Optimizing an MI355X kernel written in HIP

```python
import jax, jax.numpy as jnp
from jax import lax
import numpy as np

D_MODEL = 2048
BATCH = 2
SEQ = 4096
DEPTH = 2

D_MIX = 2048
A_HEADS = 6
A_HEAD_DIM = 128
A_WIDTH = A_HEADS * A_HEAD_DIM
Q_BLOCK = 128
B_HEADS = 4
B_HEAD_DIM = 192
B_WIDTH = B_HEADS * B_HEAD_DIM
B_CHUNK = 64
B_CONV = 4
C_GROUPS = 4
C_WIDTH = 512
C_CONV = 31
LN_EPS = 1e-5
P_HEADS = 8
P_QDIM = 256
P_HALF = P_QDIM // 2
N_KEYS = 128
N_EXPERTS = N_KEYS * N_KEYS
P_TOPK = 16
P_TOKEN_BLOCK = 64
EPS = 1e-6

SPLIT_SIZES = (A_WIDTH, A_WIDTH, A_WIDTH, A_HEADS, 2 * B_WIDTH, B_WIDTH, B_WIDTH, B_HEADS, B_HEADS, C_WIDTH, C_WIDTH)
SPLIT_POINTS = tuple(int(p) for p in np.cumsum(SPLIT_SIZES)[:-1])
N_IN = int(sum(SPLIT_SIZES))

kernel_name = 'hybrid_fox_mlstm_conformer_peer'


def rmsnorm(x, g):
    xf = x.astype(jnp.float32)
    y = xf * lax.rsqrt(jnp.mean(xf * xf, axis=-1, keepdims=True) + EPS)
    return (y * g.astype(jnp.float32)).astype(x.dtype)


def head_rmsnorm(h, g, n_heads):
    b, s, w = h.shape
    hf = h.astype(jnp.float32).reshape(b, s, n_heads, w // n_heads)
    hf = hf * lax.rsqrt(jnp.mean(hf * hf, axis=-1, keepdims=True) + EPS)
    return (hf.reshape(b, s, w) * g.astype(jnp.float32)).astype(h.dtype)


def layernorm(x, g, bias):
    xf = x.astype(jnp.float32)
    mu = jnp.mean(xf, axis=-1, keepdims=True)
    xc = xf - mu
    y = xc * lax.rsqrt(jnp.mean(xc * xc, axis=-1, keepdims=True) + LN_EPS)
    return (y * g.astype(jnp.float32) + bias.astype(jnp.float32)).astype(x.dtype)


def causal_dwconv(x, w):
    k = w.shape[0]
    return lax.conv_general_dilated(
        x, w[:, None, :].astype(x.dtype), window_strides=(1,), padding=[(k - 1, 0)],
        dimension_numbers=('NWC', 'WIO', 'NWC'), feature_group_count=x.shape[-1])


def fox_attention(q, k, v, log_f):
    b, s, h, dh = q.shape
    nb = s // Q_BLOCK
    scale = dh ** -0.5
    c = jnp.cumsum(log_f, axis=1).transpose(0, 2, 1)
    kpos = jnp.arange(s)
    q_blocks = q.reshape(b, nb, Q_BLOCK, h, dh).transpose(1, 0, 2, 3, 4)
    c_blocks = c.reshape(b, h, nb, Q_BLOCK).transpose(2, 0, 1, 3)

    def one_block(args):
        qi, ci, bi = args
        sc = jnp.einsum('bqhd,bkhd->bhqk', qi, k).astype(jnp.float32) * scale
        sc = sc + ci[..., :, None] - c[:, :, None, :]
        qpos = bi * Q_BLOCK + jnp.arange(Q_BLOCK)
        sc = jnp.where(kpos[None, :] <= qpos[:, None], sc, -jnp.inf)
        p = jax.nn.softmax(sc, axis=-1).astype(v.dtype)
        return jnp.einsum('bhqk,bkhd->bqhd', p, v)

    o = lax.map(one_block, (q_blocks, c_blocks, jnp.arange(nb)))
    return o.transpose(1, 0, 2, 3, 4).reshape(b, s, h * dh)


def mlstm_chunkwise(q, k, v, log_i, log_f):
    b, s, h, dk = q.shape
    dv = v.shape[-1]
    nc = s // B_CHUNK
    L = B_CHUNK

    def to_chunks(t):
        return t.astype(jnp.float32).reshape(b, nc, L, h, -1).transpose(1, 0, 3, 2, 4)

    def gate_chunks(g):
        return g.reshape(b, nc, L, h).transpose(1, 0, 3, 2)

    qc = to_chunks(q) * (dk ** -0.5)
    kc = to_chunks(k)
    vc = to_chunks(v)
    ic = gate_chunks(log_i)
    fc = gate_chunks(log_f)
    causal = jnp.tril(jnp.ones((L, L), dtype=bool))

    def step(carry, inp):
        cm, nm, m = carry
        qq, kk, vv, li, lf = inp
        bcum = jnp.cumsum(lf, axis=-1)
        d = jnp.where(causal, bcum[..., :, None] - bcum[..., None, :] + li[..., None, :], -jnp.inf)
        inter = bcum + m[..., None]
        m_t = jnp.maximum(inter, jnp.max(d, axis=-1))
        w_inter = jnp.exp(inter - m_t)
        sc = jnp.einsum('bhtd,bhsd->bhts', qq, kk) * jnp.exp(d - m_t[..., None])
        num = w_inter[..., None] * jnp.einsum('bhtd,bhde->bhte', qq, cm) + jnp.einsum('bhts,bhse->bhte', sc, vv)
        den = w_inter * jnp.einsum('bhtd,bhd->bht', qq, nm) + jnp.sum(sc, axis=-1)
        hh = num / jnp.maximum(jnp.abs(den), jnp.exp(-m_t))[..., None]
        b_last = bcum[..., -1]
        dec = b_last[..., None] - bcum + li
        m_new = jnp.maximum(b_last + m, jnp.max(dec, axis=-1))
        a = jnp.exp(b_last + m - m_new)
        wk = jnp.exp(dec - m_new[..., None])[..., None] * kk
        cm = a[..., None, None] * cm + jnp.einsum('bhsd,bhse->bhde', wk, vv)
        nm = a[..., None] * nm + jnp.sum(wk, axis=2)
        return (cm, nm, m_new), hh

    init = (jnp.zeros((b, h, dk, dv), jnp.float32), jnp.zeros((b, h, dk), jnp.float32), jnp.zeros((b, h), jnp.float32))
    _, hs = lax.scan(step, init, (qc, kc, vc, ic, fc))
    return hs.transpose(1, 0, 3, 2, 4).reshape(b, s, h * dv).astype(q.dtype)


def hybrid_mixer(xn, w_in, fox_f_bias, mlstm_conv_w, mlstm_i_bias, mlstm_f_bias,
                 conf_dw_w, conf_dw_b, conf_ln_g, conf_ln_b, conf_pw_w, conf_pw_b,
                 out_norm_g, w_out):
    b, s, _ = xn.shape
    z = xn @ w_in
    aq, ak, av, af, bqk, bv, bo, bi, bf, ca, cg = jnp.split(z, SPLIT_POINTS, axis=-1)

    log_fa = jax.nn.log_sigmoid((af + fox_f_bias).astype(jnp.float32))
    ya = fox_attention(aq.reshape(b, s, A_HEADS, A_HEAD_DIM), ak.reshape(b, s, A_HEADS, A_HEAD_DIM),
                       av.reshape(b, s, A_HEADS, A_HEAD_DIM), log_fa)

    qk = jax.nn.silu(causal_dwconv(bqk, mlstm_conv_w))
    bq = qk[..., :B_WIDTH].reshape(b, s, B_HEADS, B_HEAD_DIM)
    bk = qk[..., B_WIDTH:].reshape(b, s, B_HEADS, B_HEAD_DIM)
    log_ib = (bi + mlstm_i_bias).astype(jnp.float32)
    log_fb = jax.nn.log_sigmoid((bf + mlstm_f_bias).astype(jnp.float32))
    readout = mlstm_chunkwise(bq, bk, bv.reshape(b, s, B_HEADS, B_HEAD_DIM), log_ib, log_fb)
    yb = jax.nn.sigmoid(bo) * readout

    yc = ca * jax.nn.sigmoid(cg)
    yc = causal_dwconv(yc, conf_dw_w) + conf_dw_b
    yc = jax.nn.silu(layernorm(yc, conf_ln_g, conf_ln_b))
    yc = yc @ conf_pw_w + conf_pw_b

    g_a = out_norm_g[:A_WIDTH]
    g_b = out_norm_g[A_WIDTH:A_WIDTH + B_WIDTH]
    g_c = out_norm_g[A_WIDTH + B_WIDTH:]
    y = jnp.concatenate([head_rmsnorm(ya, g_a, A_HEADS), head_rmsnorm(yb, g_b, B_HEADS),
                         head_rmsnorm(yc, g_c, C_GROUPS)], axis=-1)
    return y @ w_out


def peer_ffn(xn, peer_wq, peer_keys, peer_u, peer_v):
    b, s, d = xn.shape
    t = b * s
    xt = xn.reshape(t, d)
    q = (xt @ peer_wq).reshape(t, P_HEADS, 2, P_HALF)
    sc = jnp.einsum('thcd,hcnd->thcn', q, peer_keys).astype(jnp.float32)
    vals, idx = lax.top_k(sc, P_TOPK)
    cand = vals[:, :, 0, :, None] + vals[:, :, 1, None, :]
    cand_ids = idx[:, :, 0, :, None] * N_KEYS + idx[:, :, 1, None, :]
    top_s, top_pos = lax.top_k(cand.reshape(t, P_HEADS, P_TOPK * P_TOPK), P_TOPK)
    experts = jnp.take_along_axis(cand_ids.reshape(t, P_HEADS, P_TOPK * P_TOPK), top_pos, axis=-1)
    gates = jax.nn.softmax(top_s, axis=-1)

    nb = t // P_TOKEN_BLOCK
    xb = xt.reshape(nb, P_TOKEN_BLOCK, d)
    eb = experts.reshape(nb, P_TOKEN_BLOCK, P_HEADS * P_TOPK)
    gb = gates.reshape(nb, P_TOKEN_BLOCK, P_HEADS * P_TOPK)

    def one_block(args):
        xi, ei, gi = args
        ue = jnp.take(peer_u, ei, axis=0)
        ve = jnp.take(peer_v, ei, axis=0)
        act = jax.nn.gelu(jnp.einsum('td,ted->te', xi, ue).astype(jnp.float32), approximate=False) * gi
        return jnp.einsum('te,ted->td', act.astype(ve.dtype), ve)

    out = lax.map(one_block, (xb, eb, gb))
    return out.reshape(b, s, d)


def setup_inputs(seed: int = 0) -> dict:
    key = jax.random.key(seed)
    ks = jax.random.split(key, 22)
    f32 = jnp.float32

    def nrm(k, shape, scale):
        return jax.random.normal(k, shape, f32) * scale

    return {
        'x': nrm(ks[0], (BATCH, SEQ, D_MODEL), 1.0),
        'w_in': nrm(ks[1], (DEPTH, D_MODEL, N_IN), D_MODEL ** -0.5),
        'fox_f_bias': jax.random.uniform(ks[2], (DEPTH, A_HEADS), f32, 1.0, 4.0),
        'mlstm_conv_w': nrm(ks[3], (DEPTH, B_CONV, 2 * B_WIDTH), B_CONV ** -0.5),
        'mlstm_i_bias': nrm(ks[4], (DEPTH, B_HEADS), 0.1),
        'mlstm_f_bias': jax.random.uniform(ks[5], (DEPTH, B_HEADS), f32, 3.0, 6.0),
        'conf_dw_w': nrm(ks[6], (DEPTH, C_CONV, C_WIDTH), C_CONV ** -0.5),
        'conf_dw_b': nrm(ks[7], (DEPTH, C_WIDTH), 0.02),
        'conf_ln_g': 1.0 + nrm(ks[8], (DEPTH, C_WIDTH), 0.02),
        'conf_ln_b': nrm(ks[9], (DEPTH, C_WIDTH), 0.02),
        'conf_pw_w': nrm(ks[10], (DEPTH, C_WIDTH, C_WIDTH), C_WIDTH ** -0.5),
        'conf_pw_b': nrm(ks[11], (DEPTH, C_WIDTH), 0.02),
        'out_norm_g': 1.0 + nrm(ks[12], (DEPTH, D_MIX), 0.02),
        'w_out': nrm(ks[13], (DEPTH, D_MIX, D_MODEL), D_MIX ** -0.5),
        'norm1_g': 1.0 + nrm(ks[14], (DEPTH, D_MODEL), 0.02),
        'norm2_g': 1.0 + nrm(ks[15], (DEPTH, D_MODEL), 0.02),
        'peer_wq': nrm(ks[16], (DEPTH, D_MODEL, P_HEADS * P_QDIM), D_MODEL ** -0.5),
        'peer_keys': nrm(ks[17], (DEPTH, P_HEADS, 2, N_KEYS, P_HALF), P_HALF ** -0.5),
        'peer_u': nrm(ks[18], (DEPTH, N_EXPERTS, D_MODEL), D_MODEL ** -0.5),
        'peer_v': nrm(ks[19], (DEPTH, N_EXPERTS, D_MODEL), P_HEADS ** -0.5),
        'final_g': 1.0 + nrm(ks[20], (D_MODEL,), 0.02),
    }


def reference(x, w_in, fox_f_bias, mlstm_conv_w, mlstm_i_bias, mlstm_f_bias,
              conf_dw_w, conf_dw_b, conf_ln_g, conf_ln_b, conf_pw_w, conf_pw_b,
              out_norm_g, w_out, norm1_g, norm2_g, peer_wq, peer_keys, peer_u, peer_v, final_g):
    for l in range(DEPTH):
        h = rmsnorm(x, norm1_g[l])
        x = x + hybrid_mixer(h, w_in[l], fox_f_bias[l], mlstm_conv_w[l], mlstm_i_bias[l], mlstm_f_bias[l],
                             conf_dw_w[l], conf_dw_b[l], conf_ln_g[l], conf_ln_b[l], conf_pw_w[l], conf_pw_b[l],
                             out_norm_g[l], w_out[l])
        h = rmsnorm(x, norm2_g[l])
        x = x + peer_ffn(h, peer_wq[l], peer_keys[l], peer_u[l], peer_v[l])
    return rmsnorm(x, final_g)
```

```cpp
#include <hip/hip_runtime.h>
#include <cstdio>
#include <cstdint>
namespace pg8 {
#define PG8_LAS __attribute__((address_space(3)))
typedef unsigned short bf16_t;
typedef short bf16x8 __attribute__((ext_vector_type(8)));
typedef float f32x4 __attribute__((ext_vector_type(4)));
typedef unsigned u32x4 __attribute__((ext_vector_type(4)));
constexpr int BM = 256, BK = 64, HALF = 128, HTB = HALF * BK * 2  , STAGE_BYTES = 8 * HTB, NXCD = 8, WGM = 8;

__host__ __device__ __forceinline__ int lds_byte(int r, int c) { const int st = (r >> 4) * 2 + (c >> 5), rr = r & 15, cc = c & 31, ob = rr * 64 + cc * 2; return st * 1024 + (ob ^ (((ob >> 9) & 1) << 5)); }
__host__ __device__ __forceinline__ void stage_rc(int b, int& R, int& C) { const int st = b / 1024, sb = b % 1024, swz = sb ^ (((sb >> 9) & 1) << 5); R = (st >> 1) * 16 + swz / 64; C = (st & 1) * 32 + (swz % 64) / 2; }
__host__ __device__ __forceinline__ int perm32(int rho) { const int n = rho >> 4, i = rho & 15; return 8 * (i >> 2) + 4 * n + (i & 3); }

struct Unit { int pm, pn; };
struct Gemm { const bf16_t* A; const bf16_t* Bt; int M, N, K; };

struct StaticOrder {
    int nM, nN, nwg, G, c;
    __host__ __device__ void init(int M, int N, int G_, int c_) { nM = M / BM; nN = N / BM; nwg = nM * nN; G = G_; c = c_; }
    __host__ __device__ bool next(int i, Unit& u) const {
        const long L = (long)i * G + c; if (L >= nwg) return false;
        int wgid = (int)L; { const int q = nwg / NXCD, r = nwg % NXCD, xcd = wgid % NXCD, off = wgid / NXCD; wgid = (xcd < r ? xcd * (q + 1) : r * (q + 1) + (xcd - r) * q) + off; }
        const int nig = WGM * nN, gid = wgid / nig, fm = gid * WGM, gsz = (nM - fm) < WGM ? (nM - fm) : WGM;
        u.pm = fm + ((wgid % nig) % gsz); u.pn = (wgid % nig) / gsz; return true;
    }
    __device__ __forceinline__ void a_ready(const Unit&) const {}
    __device__ __forceinline__ void done(const Unit&) const {}
};

__device__ __forceinline__ unsigned cvt_pk_bf16(float lo, float hi) { unsigned r; asm volatile("v_cvt_pk_bf16_f32 %0, %1, %2" : "=v"(r) : "v"(lo), "v"(hi)); return r; }
template <class Epi, class Sched, bool ALIGN_EPI = false, bool SP2 = false>
__device__ __forceinline__ void gemm_phase(const int tid, PG8_LAS unsigned char* lds, const Gemm g, const Sched& S, const Epi& E) {
    const int wid = __builtin_amdgcn_readfirstlane(tid >> 6), lane = tid & 63, wr = wid >> 2, wc = wid & 3, fr = lane & 15, fq = lane >> 4;
    const int K = g.K, nt = K / BK;
    unsigned voffA[2], voffB[2];
#pragma unroll
    for (int i = 0; i < 2; ++i) { int R, C; stage_rc(tid * 16 + i * 8192, R, C); const int Rb = Epi::PERM ? ((R & ~31) + perm32(R & 31)) : R;
        voffA[i] = (unsigned)(R * K + C) * 2u; voffB[i] = (unsigned)(Rb * K + C) * 2u; }
    const size_t kstep = (size_t)(BK * 2);
    const size_t hstep = (size_t)HALF * K * 2;
    const size_t tstep = 2 * hstep;
    const unsigned ldsw = (unsigned)wid * 1024u;
    const int aoff = lds_byte(wr * 64 + fr, fq * 8), boff = lds_byte(wc * 32 + fr, fq * 8);
#define PG8_SA(b, h) (((b) * 2 + (h)) * HTB)
#define PG8_SB(b, h) ((4 + (b) * 2 + (h)) * HTB)
#define PG8_STAGE(bufoff, gbase, voff) do { _Pragma("unroll") for (int _i = 0; _i < 2; ++_i) \
        __builtin_amdgcn_global_load_lds((const unsigned*)((const char*)(gbase) + (voff)[_i]), (PG8_LAS unsigned*)(lds + (bufoff) + ldsw + _i * 8192), 16, 0, 0); } while (0)
#define PG8_LDA(dst, b, h) do { _Pragma("unroll") for (int m = 0; m < 4; ++m) _Pragma("unroll") for (int k = 0; k < 2; ++k) dst[m][k] = *(const PG8_LAS bf16x8*)(lds + PG8_SA(b, h) + aoff + m * 2048 + k * 1024); } while (0)
#define PG8_LDB(dst, b, h) do { _Pragma("unroll") for (int n = 0; n < 2; ++n) _Pragma("unroll") for (int k = 0; k < 2; ++k) dst[n][k] = *(const PG8_LAS bf16x8*)(lds + PG8_SB(b, h) + boff + n * 2048 + k * 1024); } while (0)
#define PG8_MMA(ai, bj, At, Bt) do { __builtin_amdgcn_s_setprio(1); _Pragma("unroll") for (int m = 0; m < 4; ++m) _Pragma("unroll") for (int n = 0; n < 2; ++n) _Pragma("unroll") for (int k = 0; k < 2; ++k) \
        acc[ai][bj][m][n] = __builtin_amdgcn_mfma_f32_16x16x32_bf16(Bt[n][k], At[m][k], acc[ai][bj][m][n], 0, 0, 0); __builtin_amdgcn_s_setprio(0); } while (0)
#define PG8_WAIT_V(n) asm volatile("s_waitcnt vmcnt(" #n ")" ::: "memory")
#define PG8_WAIT_L(n) asm volatile("s_waitcnt lgkmcnt(" #n ")" ::: "memory")
#define PG8_BAR __builtin_amdgcn_s_barrier()
#define PG8_SCHED __builtin_amdgcn_sched_barrier(0)
    Unit cur, nxt; int ui = 0;
    if (!S.next(0, cur)) return;
    f32x4 acc[2][2][4][2];
#pragma unroll
    for (int a = 0; a < 2; ++a)
#pragma unroll
        for (int b = 0; b < 2; ++b)
#pragma unroll
            for (int m = 0; m < 4; ++m)
#pragma unroll
                for (int n = 0; n < 2; ++n) acc[a][b][m][n] = (f32x4){0.f, 0.f, 0.f, 0.f};
    bf16x8 At[4][2], B0[2][2], B1[2][2];
    const char* cA = (const char*)g.A + (size_t)cur.pm * tstep; const char* cB = (const char*)g.Bt + (size_t)cur.pn * tstep;
    if constexpr (SP2) {
        PG8_STAGE(PG8_SB(0, 0), cB, voffB); PG8_STAGE(PG8_SB(0, 1), cB + hstep, voffB); PG8_STAGE(PG8_SA(0, 0), cA, voffA); PG8_STAGE(PG8_SA(0, 1), cA + hstep, voffA);
        S.a_ready(cur);
        if (wr == 1) PG8_BAR;
        PG8_WAIT_V(2); PG8_BAR;
        PG8_STAGE(PG8_SB(1, 0), cB + kstep, voffB); PG8_STAGE(PG8_SA(1, 0), cA + kstep, voffA); PG8_STAGE(PG8_SB(1, 1), cB + hstep + kstep, voffB);
        PG8_WAIT_V(6); PG8_BAR;
    } else {
        PG8_STAGE(PG8_SB(0, 0), cB, voffB); PG8_STAGE(PG8_SA(0, 0), cA, voffA); PG8_STAGE(PG8_SB(0, 1), cB + hstep, voffB); PG8_STAGE(PG8_SA(0, 1), cA + hstep, voffA);
        S.a_ready(cur);
        if (wr == 1) PG8_BAR;
        PG8_WAIT_V(4); PG8_BAR;
        PG8_STAGE(PG8_SB(1, 0), cB + kstep, voffB); PG8_STAGE(PG8_SA(1, 0), cA + kstep, voffA); PG8_STAGE(PG8_SB(1, 1), cB + hstep + kstep, voffB);
        PG8_WAIT_V(6); PG8_BAR;
    }
    for (;;) {
        const bool has_next = S.next(ui + 1, nxt);
        const char* nA = has_next ? (const char*)g.A + (size_t)nxt.pm * tstep : cA; const char* nB = has_next ? (const char*)g.Bt + (size_t)nxt.pn * tstep : cB;
        for (int t = 0; t < nt; t += 2) {
            const bool last = (t == nt - 2);
            const char* a1 = cA + (size_t)(t + 1) * kstep;
            const char* a2 = last ? nA : cA + (size_t)(t + 2) * kstep; const char* b2 = last ? nB : cB + (size_t)(t + 2) * kstep;
            const char* a3 = a2 + kstep; const char* b3 = b2 + kstep;
            if (last && has_next) S.a_ready(nxt);
            if constexpr (SP2) {
            PG8_LDB(B0, 0, 0); PG8_LDB(B1, 0, 1); PG8_SCHED; PG8_LDA(At, 0, 0); PG8_STAGE(PG8_SA(1, 1), a1 + hstep, voffA);
            PG8_WAIT_V(8); PG8_WAIT_L(0); PG8_BAR; PG8_MMA(0, 0, At, B0); PG8_MMA(0, 1, At, B1); PG8_BAR; PG8_SCHED;
            PG8_LDA(At, 0, 1); PG8_STAGE(PG8_SB(0, 0), b2, voffB); PG8_STAGE(PG8_SB(0, 1), b2 + hstep, voffB); PG8_STAGE(PG8_SA(0, 0), a2, voffA);
            PG8_WAIT_V(8); PG8_WAIT_L(0); PG8_BAR; PG8_MMA(1, 0, At, B0); PG8_MMA(1, 1, At, B1); PG8_BAR; PG8_SCHED;
            PG8_LDB(B0, 1, 0); PG8_LDB(B1, 1, 1); PG8_SCHED; PG8_LDA(At, 1, 0); PG8_STAGE(PG8_SA(0, 1), a2 + hstep, voffA);
            PG8_WAIT_V(8); PG8_WAIT_L(0); PG8_BAR; PG8_MMA(0, 0, At, B0); PG8_MMA(0, 1, At, B1); PG8_BAR; PG8_SCHED;
            PG8_LDA(At, 1, 1); PG8_STAGE(PG8_SB(1, 0), b3, voffB); PG8_STAGE(PG8_SB(1, 1), b3 + hstep, voffB); PG8_STAGE(PG8_SA(1, 0), a3, voffA);
            PG8_WAIT_V(8); PG8_WAIT_L(0); PG8_BAR; PG8_MMA(1, 0, At, B0); PG8_MMA(1, 1, At, B1); PG8_BAR; PG8_SCHED;
            } else {
            PG8_LDB(B0, 0, 0); PG8_SCHED; PG8_LDA(At, 0, 0); PG8_STAGE(PG8_SA(1, 1), a1 + hstep, voffA);
            PG8_WAIT_L(8); PG8_BAR; PG8_WAIT_L(0); PG8_MMA(0, 0, At, B0); PG8_BAR; PG8_SCHED;
            PG8_LDB(B1, 0, 1); PG8_STAGE(PG8_SB(0, 0), b2, voffB);
            PG8_BAR; PG8_WAIT_L(0); PG8_MMA(0, 1, At, B1); PG8_BAR;
            PG8_LDA(At, 0, 1); PG8_STAGE(PG8_SA(0, 0), a2, voffA);
            PG8_BAR; PG8_WAIT_L(0); PG8_MMA(1, 0, At, B0); PG8_BAR; PG8_SCHED;
            PG8_STAGE(PG8_SB(0, 1), b2 + hstep, voffB);
            PG8_WAIT_V(6); PG8_BAR; PG8_MMA(1, 1, At, B1); PG8_BAR;
            PG8_LDB(B0, 1, 0); PG8_SCHED; PG8_LDA(At, 1, 0); PG8_STAGE(PG8_SA(0, 1), a2 + hstep, voffA);
            PG8_WAIT_L(8); PG8_BAR; PG8_WAIT_L(0); PG8_MMA(0, 0, At, B0); PG8_BAR; PG8_SCHED;
            PG8_LDB(B1, 1, 1); PG8_STAGE(PG8_SB(1, 0), b3, voffB);
            PG8_BAR; PG8_WAIT_L(0); PG8_MMA(0, 1, At, B1); PG8_BAR;
            PG8_LDA(At, 1, 1); PG8_STAGE(PG8_SA(1, 0), a3, voffA);
            PG8_BAR; PG8_WAIT_L(0); PG8_MMA(1, 0, At, B0); PG8_BAR; PG8_SCHED;
            PG8_STAGE(PG8_SB(1, 1), b3 + hstep, voffB);
            PG8_WAIT_V(6); PG8_BAR; PG8_MMA(1, 1, At, B1); PG8_BAR;
            }
        }
        if constexpr (ALIGN_EPI) { if (wr == 0) PG8_BAR; }
        if constexpr (!Epi::AFTER_DRAIN) { E(acc, cur, wr, wc, fr, fq); S.done(cur); }
        if (!has_next) break;
#pragma unroll
        for (int a = 0; a < 2; ++a)
#pragma unroll
            for (int b = 0; b < 2; ++b)
#pragma unroll
                for (int m = 0; m < 4; ++m)
#pragma unroll
                    for (int n = 0; n < 2; ++n) acc[a][b][m][n] = (f32x4){0.f, 0.f, 0.f, 0.f};
        cur = nxt; cA = nA; cB = nB; ++ui;
        if constexpr (ALIGN_EPI) { if (wr == 1) PG8_BAR; }
    }
    PG8_WAIT_V(0);
    if constexpr (!ALIGN_EPI) { if (wr == 0) PG8_BAR; }
    PG8_BAR;
    if constexpr (Epi::AFTER_DRAIN) { E.fused(acc, cur, wr, wc, fr, fq, lds, wid, lane); S.done(cur); }
#undef PG8_SA
#undef PG8_SB
#undef PG8_STAGE
#undef PG8_LDA
#undef PG8_LDB
#undef PG8_MMA
#undef PG8_WAIT_V
#undef PG8_WAIT_L
#undef PG8_BAR
#undef PG8_SCHED
}
}

#ifndef MK_ONE_LAUNCH
#define MK_ONE_LAUNCH 1
#endif
constexpr int NTOK = 8192, SEQ = 4096, DM = 2048, ZLD = 6656;
constexpr int A_H = 6, A_D = 128, B_H = 4, B_D = 192, C_W = 512, C_K = 31;
constexpr int P_H = 8, N_KEYS = 128, P_TOPK = 16, N_EXP = 16384;
constexpr int ZC_AQ = 0, ZC_AK = 768, ZC_AV = 1536, ZC_BQK = 2304, ZC_BV = 3840, ZC_BO = 4608, ZC_CA = 5376, ZC_GT = 5888, ZC_CG = 6144;
constexpr int NSUB = 11, NPHASE = 1 + 2 * NSUB;

constexpr size_t MiB = 1u << 20;
constexpr size_t WS_CTL = 0, CTL_ZERO_BYTES = 64 * 1024;
constexpr size_t WS_WIN = 2 * MiB;
constexpr size_t WS_WOUT = 56 * MiB;
constexpr size_t WS_WQ = 72 * MiB;
constexpr size_t WS_WPW = 88 * MiB;
constexpr size_t WS_EGU_ = 434 * MiB, WS_PS_ = 640 * MiB, LSTRIDE_ = 116 * MiB;
constexpr size_t WS_KH = 90 * MiB, WS_KL = 91 * MiB;
constexpr size_t WS_X = 96 * MiB;
constexpr size_t WS_HN = 160 * MiB;
constexpr size_t WS_Z = 192 * MiB;
constexpr size_t WS_GATE = 296 * MiB;
constexpr size_t WS_CFOX = 297 * MiB;
constexpr size_t WS_Y = 298 * MiB;
constexpr size_t WS_CACT = 330 * MiB;
constexpr size_t WS_YCR = 338 * MiB;
constexpr size_t WS_Q = 354 * MiB;
constexpr size_t WS_EIDX = 418 * MiB;
constexpr size_t WS_EGATE = 422 * MiB;
constexpr size_t WS_P2 = 808 * MiB;
constexpr size_t WS_END = 810 * MiB;

constexpr int RING_BYTES = 131072;
constexpr int MISC_OFF = RING_BYTES;
constexpr int RS_OFF = RING_BYTES + 1024;
constexpr int RT_TAB_OFF = RS_OFF + 4096;
constexpr int LDS_BYTES = RING_BYTES + 1024 + 4096 + 8448;

typedef unsigned short bf16_t;
typedef float f32x4 __attribute__((ext_vector_type(4)));
typedef unsigned u32x4 __attribute__((ext_vector_type(4)));
typedef unsigned u32x2 __attribute__((ext_vector_type(2)));
#define LAS __attribute__((address_space(3)))

__device__ __forceinline__ unsigned f2bf(float f) { unsigned u = __builtin_bit_cast(unsigned, f); return (u + 0x7fffu + ((u >> 16) & 1u)) >> 16; }
__device__ __forceinline__ unsigned pk2(float lo, float hi) { return f2bf(lo) | (f2bf(hi) << 16); }
__device__ __forceinline__ float bf_lo(unsigned w) { return __builtin_bit_cast(float, w << 16); }
__device__ __forceinline__ float bf_hi(unsigned w) { return __builtin_bit_cast(float, w & 0xffff0000u); }
__device__ __forceinline__ float bf2f(bf16_t b) { return __builtin_bit_cast(float, ((unsigned)b) << 16); }
#define SHX(v, m) __builtin_bit_cast(float, __builtin_amdgcn_ds_bpermute(((lane) ^ (m)) << 2, __builtin_bit_cast(int, (float)(v))))
#define SHXI(v, m) __builtin_amdgcn_ds_bpermute(((lane) ^ (m)) << 2, (int)(v))
#define SHUP(v, d) __builtin_bit_cast(float, __builtin_amdgcn_ds_bpermute((((lane) >= (d)) ? (lane) - (d) : (lane)) << 2, __builtin_bit_cast(int, (float)(v))))
#define SHIDX(v, s) __builtin_bit_cast(float, __builtin_amdgcn_ds_bpermute((s) << 2, __builtin_bit_cast(int, (float)(v))))
#define SHIDXI(v, s) __builtin_amdgcn_ds_bpermute((s) << 2, (int)(v))
#define RDLANE(v, k) __builtin_bit_cast(float, __builtin_amdgcn_readlane(__builtin_bit_cast(int, (float)(v)), (k)))
__device__ __forceinline__ float wave_sum(float v, const int lane) {
#pragma unroll
    for (int o = 32; o > 0; o >>= 1) v += SHX(v, o);
    return v;
}
__device__ __forceinline__ float wave_max(float v, const int lane) {
#pragma unroll
    for (int o = 32; o > 0; o >>= 1) v = fmaxf(v, SHX(v, o));
    return v;
}
__device__ __forceinline__ float sigmoidf_(float x) { return __builtin_amdgcn_rcpf(1.f + __expf(-x)); }
__device__ __forceinline__ float log_sigmoidf_(float x) { return fminf(x, 0.f) - log1pf(__expf(-fabsf(x))); }
#define LDS_FENCE() asm volatile("s_waitcnt lgkmcnt(0)" ::: "memory")

#define XB_TMO      128
#define XB_XCNT(j)  (256  + 64 * (j))
#define XB_XSUB(j)  (1280 + 64 * (j))
#define XB_XGEN(j)  (2304 + 64 * (j))
#define XB_TOP      3328
#define XB_TOPGEN   3392
#define XCD_BAR_WORDS 3456
#define XB_SPIN_CAP (1u << 22)
__device__ __forceinline__ unsigned xb_ld(unsigned* p)              { return __hip_atomic_load(p, __ATOMIC_RELAXED, __HIP_MEMORY_SCOPE_AGENT); }
__device__ __forceinline__ unsigned xb_add(unsigned* p, unsigned v) { return __hip_atomic_fetch_add(p, v, __ATOMIC_RELAXED, __HIP_MEMORY_SCOPE_AGENT); }
__device__ __forceinline__ unsigned xb_xcc_id() { return (unsigned)__builtin_amdgcn_s_getreg((3 << 11) | 20) & 0xFu; }
#define XB_SPIN(cond, bar) do { unsigned _sp = 0; while (cond) { __builtin_amdgcn_s_sleep(1); \
    if ((++_sp & 255u) == 0u) { if (xb_ld(&(bar)[XB_TMO])) break; if (_sp > XB_SPIN_CAP) { atomicAdd(&(bar)[XB_TMO], 1u); break; } } } } while (0)
struct XcdBarrier { unsigned* bar; unsigned x; volatile LAS unsigned* st; };
__device__ __forceinline__ XcdBarrier xcd_barrier_post(unsigned* bar, volatile LAS unsigned* st, const int tid) {
    XcdBarrier b; b.bar = bar; b.x = xb_xcc_id(); b.st = st;
    if (tid == 0) (void)xb_add(&bar[XB_XCNT(b.x)], 1u);
    return b;
}
__device__ __forceinline__ void xcd_barrier_complete(unsigned* bar, unsigned x, unsigned& nloc, unsigned& nx) {
    const unsigned G = gridDim.x * gridDim.y * gridDim.z;
    unsigned sum, cnt, mine, sp = 0u;
    for (;;) {
        sum = 0u; cnt = 0u; mine = 0u;
#pragma unroll
        for (unsigned j = 0; j < 16; ++j) { const unsigned c = xb_ld(&bar[XB_XCNT(j)]); sum += c; cnt += (c > 0u) ? 1u : 0u; mine = (j == x) ? c : mine; }
        if (sum == G) break;
        __builtin_amdgcn_s_sleep(1);
        if ((++sp & 255u) == 0u) { if (xb_ld(&bar[XB_TMO])) break; if (sp > XB_SPIN_CAP) { atomicAdd(&bar[XB_TMO], 1u); break; } }
    }
    nloc = mine > 0u ? mine : 1u; nx = cnt > 0u ? cnt : 1u;
}
__device__ __forceinline__ void xcd_barrier(const XcdBarrier& b, const int tid) {
    asm volatile("s_waitcnt vmcnt(0)" ::: "memory");
    __syncthreads();
    if (tid == 0) {
        unsigned* bar = b.bar;
        __builtin_amdgcn_s_waitcnt(0);
        unsigned nloc = b.st[0], nx = b.st[1];
        if (nloc == 0u) { xcd_barrier_complete(bar, b.x, nloc, nx); b.st[0] = nloc; b.st[1] = nx; }
        const unsigned old = xb_add(&bar[XB_XSUB(b.x)], 1u);
        const unsigned gen = old / nloc;
        if (old + 1u == (gen + 1u) * nloc) {
            __builtin_amdgcn_fence(__ATOMIC_RELEASE, "agent");
            asm volatile("s_waitcnt vmcnt(0)" ::: "memory");
            const unsigned og = xb_add(&bar[XB_TOP], 1u);
            const unsigned tg = og / nx;
            if (og + 1u == (tg + 1u) * nx) xb_add(&bar[XB_TOPGEN], 1u);
            else XB_SPIN(xb_ld(&bar[XB_TOPGEN]) == tg, bar);
            __builtin_amdgcn_fence(__ATOMIC_ACQUIRE, "agent");
            xb_add(&bar[XB_XGEN(b.x)], 1u);
            asm volatile("s_waitcnt vmcnt(0)" ::: "memory");
        } else {
            XB_SPIN(xb_ld(&bar[XB_XGEN(b.x)]) == gen, bar);
            __builtin_amdgcn_fence(__ATOMIC_ACQUIRE, "agent");
            asm volatile("s_waitcnt vmcnt(0)" ::: "memory");
        }
    }
    __syncthreads();
}

struct Args { const float* in[21]; float* out; unsigned char* ws; int ph_lo, ph_hi; };
typedef const __attribute__((address_space(4))) Args* ArgsP;
enum { I_X = 0, I_WIN, I_FOXB, I_MCONVW, I_MIB, I_MFB, I_CDWW, I_CDWB, I_CLNG, I_CLNB, I_CPWW, I_CPWB, I_ONG, I_WOUT, I_N1G, I_N2G, I_PWQ, I_PKEYS, I_PU, I_PV, I_FING };

__device__ __forceinline__ int lane_now() { int l; asm volatile("v_mbcnt_lo_u32_b32 %0, -1, 0\n\tv_mbcnt_hi_u32_b32 %0, -1, %0" : "=v"(l)); return l; }
struct EpiZ {
    static constexpr bool PERM = true, AFTER_DRAIN = false;
    bf16_t* Z; float* G; int col_off, gate_tile; const LAS float* rsb; mutable int k;
    __device__ __forceinline__ void operator()(const pg8::f32x4 (&acc)[2][2][4][2], const pg8::Unit& u, int wr, int wc, int fr, int fq) const {
        const int row0 = u.pm * 256 + wr * 64 + fr;
        const LAS float* rr = rsb + (k & 3) * 256 + wr * 64 + fr; ++k;
        if (u.pn != gate_tile) {
            const int col0 = col_off + u.pn * 256 + wc * 32 + 8 * fq;
#pragma unroll
            for (int ai = 0; ai < 2; ++ai)
#pragma unroll
                for (int m = 0; m < 4; ++m) { bf16_t* rowp = Z + (size_t)(row0 + ai * 128 + m * 16) * ZLD + col0; const float rs = rr[ai * 128 + m * 16];
#pragma unroll
                    for (int bj = 0; bj < 2; ++bj) { const pg8::f32x4 v0 = acc[ai][bj][m][0] * rs, v1 = acc[ai][bj][m][1] * rs; u32x4 w;
                        w.x = pg8::cvt_pk_bf16(v0[0], v0[1]); w.y = pg8::cvt_pk_bf16(v0[2], v0[3]); w.z = pg8::cvt_pk_bf16(v1[0], v1[1]); w.w = pg8::cvt_pk_bf16(v1[2], v1[3]);
                        *(u32x4*)(rowp + bj * 128) = w; } }
        } else if (wc == 0 && fq < 2) {
#pragma unroll
            for (int ai = 0; ai < 2; ++ai)
#pragma unroll
                for (int m = 0; m < 4; ++m) { float* gp = G + (size_t)(row0 + ai * 128 + m * 16) * 16 + 8 * fq; const float rs = rr[ai * 128 + m * 16];
                    *(pg8::f32x4*)gp = acc[ai][0][m][0] * rs; *(pg8::f32x4*)(gp + 4) = acc[ai][0][m][1] * rs; }
        }
    }
};
struct EpiResidN {
    static constexpr bool PERM = true, AFTER_DRAIN = false;
    const float* Xin; float* Xout; bf16_t* HN; const float* gain; float* P;
    __device__ __forceinline__ void operator()(const pg8::f32x4 (&acc)[2][2][4][2], const pg8::Unit& u, int wr, int wc, int fr, int fq) const {
        const int lane = fr + 16 * fq;
        const int row0 = u.pm * 256 + wr * 64 + fr, col0 = u.pn * 256 + wc * 32 + 8 * fq;
        pg8::f32x4 gv[2][2];
#pragma unroll
        for (int bj = 0; bj < 2; ++bj) { gv[bj][0] = *(const pg8::f32x4*)(gain + col0 + bj * 128); gv[bj][1] = *(const pg8::f32x4*)(gain + col0 + bj * 128 + 4); }
#pragma unroll
        for (int ai = 0; ai < 2; ++ai)
#pragma unroll
          for (int mp = 0; mp < 2; ++mp) {
            pg8::f32x4 xin[2][2][2];
#pragma unroll
            for (int mm = 0; mm < 2; ++mm)
#pragma unroll
                for (int bj = 0; bj < 2; ++bj) { const size_t off = (size_t)(row0 + ai * 128 + (2 * mp + mm) * 16) * DM + col0 + bj * 128;
                    xin[mm][bj][0] = *(const pg8::f32x4*)(Xin + off); xin[mm][bj][1] = *(const pg8::f32x4*)(Xin + off + 4); }
#pragma unroll
            for (int mm = 0; mm < 2; ++mm) { const int m = 2 * mp + mm; const int row = row0 + ai * 128 + m * 16; const size_t off = (size_t)row * DM + col0;
                float ss = 0.f;
#pragma unroll
                for (int bj = 0; bj < 2; ++bj) {
                    const pg8::f32x4 x0 = xin[mm][bj][0] + acc[ai][bj][m][0], x1 = xin[mm][bj][1] + acc[ai][bj][m][1];
                    *(pg8::f32x4*)(Xout + off + bj * 128) = x0; *(pg8::f32x4*)(Xout + off + bj * 128 + 4) = x1;
                    ss += ((x0[0] * x0[0] + x0[1] * x0[1]) + (x0[2] * x0[2] + x0[3] * x0[3])) + ((x1[0] * x1[0] + x1[1] * x1[1]) + (x1[2] * x1[2] + x1[3] * x1[3]));
                    const pg8::f32x4 h0 = x0 * gv[bj][0], h1 = x1 * gv[bj][1]; u32x4 w;
                    w.x = pg8::cvt_pk_bf16(h0[0], h0[1]); w.y = pg8::cvt_pk_bf16(h0[2], h0[3]); w.z = pg8::cvt_pk_bf16(h1[0], h1[1]); w.w = pg8::cvt_pk_bf16(h1[2], h1[3]);
                    *(u32x4*)(HN + off + bj * 128) = w; }
                ss += SHX(ss, 16); ss += SHX(ss, 32);
                if (fq == 0) P[(size_t)(u.pn * 4 + wc) * NTOK + row] = ss; }
          }
    }
};
struct EpiF32 {
    static constexpr bool PERM = false, AFTER_DRAIN = false;
    float* C; int ldc; const float* bias;
    __device__ __forceinline__ void operator()(const pg8::f32x4 (&acc)[2][2][4][2], const pg8::Unit& u, int wr, int wc, int fr, int fq) const {
        const int row0 = u.pm * 256 + wr * 64 + fr, col0 = u.pn * 256 + wc * 32 + 4 * fq;
        pg8::f32x4 bv[2][2];
#pragma unroll
        for (int bj = 0; bj < 2; ++bj)
#pragma unroll
            for (int n = 0; n < 2; ++n) bv[bj][n] = bias ? *(const pg8::f32x4*)(bias + col0 + bj * 128 + n * 16) : (pg8::f32x4){0.f, 0.f, 0.f, 0.f};
#pragma unroll
        for (int ai = 0; ai < 2; ++ai)
#pragma unroll
            for (int m = 0; m < 4; ++m) { float* rowp = C + (size_t)(row0 + ai * 128 + m * 16) * ldc + col0;
#pragma unroll
                for (int bj = 0; bj < 2; ++bj)
#pragma unroll
                    for (int n = 0; n < 2; ++n) *(pg8::f32x4*)(rowp + bj * 128 + n * 16) = acc[ai][bj][m][n] + bv[bj][n]; }
    }
};

struct EpiF32R {
    static constexpr bool PERM = false, AFTER_DRAIN = false;
    float* C; int ldc; const LAS float* rsb; mutable int k;
    __device__ __forceinline__ void operator()(const pg8::f32x4 (&acc)[2][2][4][2], const pg8::Unit& u, int wr, int wc, int fr, int fq) const {
        const int row0 = u.pm * 256 + wr * 64 + fr, col0 = u.pn * 256 + wc * 32 + 4 * fq;
        const LAS float* rr = rsb + (k & 3) * 256 + wr * 64 + fr; ++k;
#pragma unroll
        for (int ai = 0; ai < 2; ++ai)
#pragma unroll
            for (int m = 0; m < 4; ++m) { float* rowp = C + (size_t)(row0 + ai * 128 + m * 16) * ldc + col0; const float rs = rr[ai * 128 + m * 16];
#pragma unroll
                for (int bj = 0; bj < 2; ++bj)
#pragma unroll
                    for (int n = 0; n < 2; ++n) *(pg8::f32x4*)(rowp + bj * 128 + n * 16) = acc[ai][bj][m][n] * rs; }
    }
};
struct RsOrder {
    pg8::StaticOrder S; const float* P; int np; LAS float* rsb; int wave_s; mutable int k;
    __device__ __forceinline__ bool next(int i, pg8::Unit& u) const { return S.next(i, u); }
    __device__ __forceinline__ void a_ready(const pg8::Unit& u) const {
        if (k == 0) { const int t = wave_s * 64 + lane_now();
            if (t < 256) {
#pragma unroll 1
                for (int i = 0; i < 4; ++i) { pg8::Unit v; if (!S.next(i, v)) break;
                    float s = 0.f; const float* p = P + v.pm * 256 + t;
                    if (np == 32) { float x[32];
#pragma unroll
                        for (int q = 0; q < 32; ++q) x[q] = p[(size_t)q * NTOK];
#pragma unroll
                        for (int q = 0; q < 32; q += 8) s += ((x[q] + x[q + 1]) + (x[q + 2] + x[q + 3])) + ((x[q + 4] + x[q + 5]) + (x[q + 6] + x[q + 7])); }
                    else
#pragma unroll 1
                    for (int j = 0; j < np; j += 8) { float x[8];
#pragma unroll
                        for (int q = 0; q < 8; ++q) x[q] = p[(size_t)(j + q) * NTOK];
                        s += ((x[0] + x[1]) + (x[2] + x[3])) + ((x[4] + x[5]) + (x[6] + x[7])); }
                    rsb[i * 256 + t] = np ? rsqrtf(s * (1.f / DM) + 1e-6f) : 1.f; } } }
        ++k; }
    __device__ __forceinline__ void done(const pg8::Unit&) const {}
};
__device__ __forceinline__ int win_src(int n) {
    if (n < 2304) return n;
    if (n < 5376) return n + 6;
    if (n < 5888) return n + 14;
    if (n < 6144) { const int g = n - 5888;
        if (g < 6) return 2304 + g;
        if (g < 14) return 5382 + (g - 6);
        return -1; }
    return 5902 + (n - 6144);
}
typedef float f32x2 __attribute__((ext_vector_type(2)));
__device__ __forceinline__ void transpose_item(const float* W, int K, int N, bf16_t* WT, int NB, float* scr, int item, int lane, bool winmap) {
    const int kb = item / NB, nb = item % NB, k0 = 64 * kb, n0 = 32 * nb;
    const int np = n0 + 2 * (lane & 15);
    const int src = winmap ? win_src(np) : np;
    const int src1 = winmap ? win_src(np + 1) : np + 1;
    f32x2 v[16];
    const bool pairok = src >= 0 && src1 == src + 1;
    if (__builtin_amdgcn_ballot_w64(!pairok) == 0ull) {
#pragma unroll
        for (int i = 0; i < 16; ++i) { const int kk = 4 * i + (lane >> 4); v[i] = *(const f32x2*)(W + (size_t)(k0 + kk) * N + src); }
    } else {
#pragma unroll
        for (int i = 0; i < 16; ++i) { const int kk = 4 * i + (lane >> 4);
            const float xa = W[(size_t)(k0 + kk) * N + (src >= 0 ? src : 0)], xb = W[(size_t)(k0 + kk) * N + (src1 >= 0 ? src1 : 0)];
            v[i].x = (src >= 0) ? xa : 0.f; v[i].y = (src1 >= 0) ? xb : 0.f; }
    }
#pragma unroll
    for (int i = 0; i < 16; ++i) { const int kk = 4 * i + (lane >> 4); scr[kk * 33 + 2 * (lane & 15)] = v[i].x; scr[kk * 33 + 2 * (lane & 15) + 1] = v[i].y; }
    LDS_FENCE();
    const int c = lane & 7;
#pragma unroll
    for (int j = 0; j < 4; ++j) { const int n = (lane >> 3) + 8 * j; const float* s = scr + (8 * c) * 33 + n;
        u32x4 o; o.x = pk2(s[0 * 33], s[1 * 33]); o.y = pk2(s[2 * 33], s[3 * 33]); o.z = pk2(s[4 * 33], s[5 * 33]); o.w = pk2(s[6 * 33], s[7 * 33]);
        *(u32x4*)(WT + (size_t)(n0 + n) * K + k0 + 8 * c) = o; }
    LDS_FENCE();
}
__device__ __forceinline__ void rmsnorm_row_bf16(const float* xr, const float* g, bf16_t* o, int lane) {
    f32x4 v[8], gv[8]; float s = 0.f;
#pragma unroll
    for (int j = 0; j < 8; ++j) { v[j] = ((const f32x4*)xr)[lane + 64 * j]; gv[j] = ((const f32x4*)g)[lane + 64 * j]; }
#pragma unroll
    for (int j = 0; j < 8; ++j) s += (v[j].x * v[j].x + v[j].y * v[j].y) + (v[j].z * v[j].z + v[j].w * v[j].w);
    const float r = rsqrtf(wave_sum(s, lane) * (1.f / DM) + 1e-6f);
#pragma unroll
    for (int j = 0; j < 8; ++j) { const f32x4 gg = gv[j]; u32x2 w; w.x = pk2(v[j].x * r * gg.x, v[j].y * r * gg.y); w.y = pk2(v[j].z * r * gg.z, v[j].w * r * gg.w);
        ((u32x2*)o)[lane + 64 * j] = w; }
}

__device__ __forceinline__ void phase_prologue(ArgsP a, const int tid, unsigned char* lds) {
    const int lane = tid & 63, wave = tid >> 6, G = gridDim.x;
    float* scr = (float*)lds + wave * (64 * 33);
    const int gw = blockIdx.x * 8 + wave, NGW = G * 8;
    constexpr int I_IN = 32 * 208, I_SQ = 32 * 64, I_PW = 8 * 16, I_L = I_IN + 2 * I_SQ + I_PW;
    for (int it = gw; it < 2 * I_L; it += NGW) {
        const int l = it / I_L; int r = it % I_L;
        if (r < I_IN) { transpose_item(a->in[I_WIN] + (size_t)l * DM * 6414, DM, 6414, (bf16_t*)(a->ws + WS_WIN) + (size_t)l * ZLD * DM, 208, scr, r, lane, true); continue; } r -= I_IN;
        if (r < I_SQ) { transpose_item(a->in[I_WOUT] + (size_t)l * DM * DM, DM, DM, (bf16_t*)(a->ws + WS_WOUT) + (size_t)l * DM * DM, 64, scr, r, lane, false); continue; } r -= I_SQ;
        if (r < I_SQ) { transpose_item(a->in[I_PWQ] + (size_t)l * DM * DM, DM, DM, (bf16_t*)(a->ws + WS_WQ) + (size_t)l * DM * DM, 64, scr, r, lane, false); continue; } r -= I_SQ;
        transpose_item(a->in[I_CPWW] + (size_t)l * C_W * C_W, C_W, C_W, (bf16_t*)(a->ws + WS_WPW) + (size_t)l * C_W * C_W, 16, scr, r, lane, false);
    }
    for (int m = gw; m < NTOK; m += NGW) rmsnorm_row_bf16(a->in[I_X] + (size_t)m * DM, a->in[I_N1G], (bf16_t*)(a->ws + WS_HN) + (size_t)m * DM, lane);
    for (int i = blockIdx.x * 512 + tid; i < 2 * P_H * 2 * N_KEYS * 128 / 8; i += G * 512) {
        const f32x4 x0 = ((const f32x4*)a->in[I_PKEYS])[2 * i], x1 = ((const f32x4*)a->in[I_PKEYS])[2 * i + 1];
        const unsigned h0 = f2bf(x0.x), h1 = f2bf(x0.y), h2 = f2bf(x0.z), h3 = f2bf(x0.w), h4 = f2bf(x1.x), h5 = f2bf(x1.y), h6 = f2bf(x1.z), h7 = f2bf(x1.w);
        u32x4 wh, wl; wh.x = h0 | (h1 << 16); wh.y = h2 | (h3 << 16); wh.z = h4 | (h5 << 16); wh.w = h6 | (h7 << 16);
        wl.x = pk2(x0.x - bf_lo(h0), x0.y - bf_lo(h1)); wl.y = pk2(x0.z - bf_lo(h2), x0.w - bf_lo(h3)); wl.z = pk2(x1.x - bf_lo(h4), x1.y - bf_lo(h5)); wl.w = pk2(x1.z - bf_lo(h6), x1.w - bf_lo(h7));
        ((u32x4*)(a->ws + WS_KH))[i] = wh; ((u32x4*)(a->ws + WS_KL))[i] = wl;
    }
}

__device__ __forceinline__ void phase_gateprep(ArgsP a, const int tid, int layer, unsigned char* lds, const int bh) {
    const int lane = tid & 63, wave = tid >> 6;
    if (bh < 0 || bh >= 12) return;
    const int b = bh / A_H, h = bh % A_H;
    const float* gate = (const float*)(a->ws + WS_GATE);
    float* cf = (float*)(a->ws + WS_CFOX) + (size_t)bh * SEQ;
    float* wtot = (float*)lds;
    const float fb = a->in[I_FOXB][layer * A_H + h];
    float v[8]; float s = 0.f;
#pragma unroll
    for (int i = 0; i < 8; ++i) { v[i] = log_sigmoidf_(gate[(size_t)(b * SEQ + tid * 8 + i) * 16 + h] + fb); s += v[i]; }
    float incl = s;
#pragma unroll
    for (int o = 1; o < 64; o <<= 1) { const float t = SHUP(incl, o); if (lane >= o) incl += t; }
    __syncthreads();
    if (lane == 63) wtot[wave] = incl;
    __syncthreads();
    float run = incl - s;
#pragma unroll
    for (int w = 0; w < 8; ++w) if (w < wave) run += wtot[w];
    f32x4 o0, o1;
    run += v[0]; o0.x = run; run += v[1]; o0.y = run; run += v[2]; o0.z = run; run += v[3]; o0.w = run;
    run += v[4]; o1.x = run; run += v[5]; o1.y = run; run += v[6]; o1.z = run; run += v[7]; o1.w = run;
    *(f32x4*)(cf + tid * 8) = o0; *(f32x4*)(cf + tid * 8 + 4) = o1;
}

typedef short bf16x8 __attribute__((ext_vector_type(8)));
typedef short s16x4 __attribute__((ext_vector_type(4)));
constexpr int MSTR = 200;
constexpr int PSTR = 72;
constexpr size_t WS_MDC = 512 * MiB;
constexpr size_t WS_MDN = 552 * MiB;
constexpr size_t WS_MSC = 553 * MiB;
constexpr size_t WS_MKC = 448 * MiB;
__device__ __forceinline__ s16x4 tr16(const bf16_t* p) {
    return __builtin_bit_cast(s16x4, __builtin_amdgcn_ds_read_tr16_b64_v4i16((__attribute__((address_space(3))) s16x4*)p));
}
__device__ __forceinline__ bf16x8 cat8(s16x4 lo, s16x4 hi) { return (bf16x8){lo[0], lo[1], lo[2], lo[3], hi[0], hi[1], hi[2], hi[3]}; }
__device__ __forceinline__ void unpack8(const u32x4 w, float (&f)[8]) { f[0] = bf_lo(w.x); f[1] = bf_hi(w.x); f[2] = bf_lo(w.y); f[3] = bf_hi(w.y); f[4] = bf_lo(w.z); f[5] = bf_hi(w.z); f[6] = bf_lo(w.w); f[7] = bf_hi(w.w); }
__device__ __forceinline__ void conv8_silu(const bf16_t* zrow, int t, int zc, const float* cw, float (&o)[8], const bool full) {
#pragma unroll
    for (int i = 0; i < 8; ++i) o[i] = 0.f;
    if (full) {
        u32x4 xr[4]; f32x4 w0[4], w1[4];
#pragma unroll
        for (int j = 0; j < 4; ++j) { xr[j] = *(const u32x4*)(zrow - (size_t)(3 - j) * ZLD + zc); w0[j] = *(const f32x4*)(cw + j * 1536); w1[j] = *(const f32x4*)(cw + j * 1536 + 4); }
#pragma unroll
        for (int j = 0; j < 4; ++j) {
            float x[8]; unpack8(xr[j], x);
            o[0] += w0[j].x * x[0]; o[1] += w0[j].y * x[1]; o[2] += w0[j].z * x[2]; o[3] += w0[j].w * x[3]; o[4] += w1[j].x * x[4]; o[5] += w1[j].y * x[5]; o[6] += w1[j].z * x[6]; o[7] += w1[j].w * x[7];
        }
    } else
#pragma unroll
    for (int j = 0; j < 4; ++j) {
        if (t - 3 + j >= 0) {
            float x[8]; unpack8(*(const u32x4*)(zrow - (size_t)(3 - j) * ZLD + zc), x);
            const f32x4 w0 = *(const f32x4*)(cw + j * 1536), w1 = *(const f32x4*)(cw + j * 1536 + 4);
            o[0] += w0.x * x[0]; o[1] += w0.y * x[1]; o[2] += w0.z * x[2]; o[3] += w0.w * x[3]; o[4] += w1.x * x[4]; o[5] += w1.y * x[5]; o[6] += w1.z * x[6]; o[7] += w1.w * x[7];
        }
    }
#pragma unroll
    for (int i = 0; i < 8; ++i) o[i] = o[i] * sigmoidf_(o[i]);
}
__device__ __forceinline__ u32x4 pack8f(const float (&f)[8], float s) { u32x4 w; w.x = pk2(f[0] * s, f[1] * s); w.y = pk2(f[2] * s, f[3] * s); w.z = pk2(f[4] * s, f[5] * s); w.w = pk2(f[6] * s, f[7] * s); return w; }

__device__ __forceinline__ void mlstm_b1_item(ArgsP a, const int tid, int layer, unsigned char* lds, int item) {
    const int lane = tid & 63, wave = __builtin_amdgcn_readfirstlane(tid >> 6);
    const int bh = item >> 6, c = item & 63, b = bh >> 2, h = bh & 3;
    const size_t tok0 = (size_t)b * SEQ + c * 64;
    bf16_t* KS = (bf16_t*)lds; bf16_t* VS = KS + 64 * MSTR; float* wts = (float*)(VS + 64 * MSTR);
    unsigned char* ws = a->ws;
    const bf16_t* Z = (const bf16_t*)(ws + WS_Z);
    const float* gate = (const float*)(ws + WS_GATE);
    float* MSC = (float*)(ws + WS_MSC);
    __syncthreads();
    if (wave == 0) {
        const float li = gate[(tok0 + lane) * 16 + 6 + h] + a->in[I_MIB][layer * B_H + h];
        const float lf = log_sigmoidf_(gate[(tok0 + lane) * 16 + 10 + h] + a->in[I_MFB][layer * B_H + h]);
        float bc = lf;
#pragma unroll
        for (int o = 1; o < 64; o <<= 1) { const float t = SHUP(bc, o); if (lane >= o) bc += t; }
        const float blast = RDLANE(bc, 63);
        const float dec = blast - bc + li;
        const float mloc = wave_max(dec, lane);
        wts[lane] = __expf(dec - mloc);
        if (lane == 0) { MSC[item] = mloc; MSC[512 + item] = blast; }
    }
    __syncthreads();
    {
        const float* cwk = a->in[I_MCONVW] + (size_t)layer * 4 * 1536 + 768 + h * B_D;
#pragma unroll
        for (int o = 0; o < 3; ++o) {
            const int idx = tid + 512 * o, s = idx / 24, ch = (idx % 24) * 8, t = c * 64 + s;
            const bf16_t* zrow = Z + (tok0 + s) * ZLD;
            float kv[8]; conv8_silu(zrow, t, ZC_BQK + 768 + h * B_D + ch, cwk + ch, kv, c > 0);
            *(u32x4*)(KS + s * MSTR + ch) = pack8f(kv, wts[s]);
            *(u32x4*)((bf16_t*)(ws + WS_MKC) + ((size_t)item * 64 + s) * B_D + ch) = pack8f(kv, 1.f);
            *(u32x4*)(VS + s * MSTR + ch) = *(const u32x4*)(zrow + ZC_BV + h * B_D + ch);
        }
    }
    __syncthreads();
    if (tid < B_D) { float dn = 0.f;
#pragma unroll
        for (int s0 = 0; s0 < 64; s0 += 16) { bf16_t t16[16];
#pragma unroll
            for (int k = 0; k < 16; ++k) t16[k] = KS[(s0 + k) * MSTR + tid];
            asm volatile("" ::: "memory");
            float p0 = 0.f, p1 = 0.f, p2 = 0.f, p3 = 0.f;
#pragma unroll
            for (int k = 0; k < 4; ++k) { p0 += bf2f(t16[4 * k]); p1 += bf2f(t16[4 * k + 1]); p2 += bf2f(t16[4 * k + 2]); p3 += bf2f(t16[4 * k + 3]); }
            dn += (p0 + p1) + (p2 + p3); }
        ((float*)(ws + WS_MDN))[(size_t)item * B_D + tid] = dn; }
    const int i16 = lane & 15, g4 = lane >> 4;
    bf16_t* DC = (bf16_t*)(ws + WS_MDC) + (size_t)item * B_D * B_D;
    for (int i = 0; i < 18; ++i) {
        const int idx = wave + 8 * i, dt = idx / 12, et = idx % 12;
        f32x4 acc = (f32x4){0.f, 0.f, 0.f, 0.f};
#pragma unroll
        for (int ks = 0; ks < 2; ++ks) {
            const int s0 = 32 * ks + 8 * g4 + (i16 >> 2), cc = 4 * (i16 & 3);
            const bf16x8 A = cat8(tr16(KS + s0 * MSTR + 16 * dt + cc), tr16(KS + (s0 + 4) * MSTR + 16 * dt + cc));
            const bf16x8 B = cat8(tr16(VS + s0 * MSTR + 16 * et + cc), tr16(VS + (s0 + 4) * MSTR + 16 * et + cc));
            acc = __builtin_amdgcn_mfma_f32_16x16x32_bf16(A, B, acc, 0, 0, 0);
        }
        u32x2 w; w.x = pk2(acc[0], acc[1]); w.y = pk2(acc[2], acc[3]);
        *(u32x2*)(DC + (size_t)(16 * et + i16) * B_D + 16 * dt + 4 * g4) = w;
    }
}

constexpr int NSCAN = 8 * B_D * 48 / 512;
__device__ __forceinline__ void mlstm_scan_piece(ArgsP a, const int tid, unsigned char* lds, int idx) {
    unsigned char* ws = a->ws;
    const float* MSC = (const float*)(ws + WS_MSC);
    float* msc_s = (float*)lds;
    float* coef = msc_s + 256;
    float* mns = coef + 256;
    const int it0 = idx * 512, bh0 = it0 / (B_D * 48), bh1 = (it0 + 511) / (B_D * 48);
    __syncthreads();
    if (tid < 256) { const int t2 = tid >> 7, k = tid & 127, bh = t2 ? bh1 : bh0; msc_s[tid] = MSC[(k >> 6) * 512 + bh * 64 + (k & 63)]; }
    __syncthreads();
    if (tid < 2) { float mm = 0.f;
#pragma unroll 1
        for (int c = 0; c < 64; ++c) { const float mloc = msc_s[tid * 128 + c], bl = msc_s[tid * 128 + 64 + c];
            const float mn = fmaxf(bl + mm, mloc); coef[(tid * 64 + c) * 2] = __expf(bl + mm - mn); coef[(tid * 64 + c) * 2 + 1] = __expf(mloc - mn); mns[tid * 64 + c] = mn; mm = mn; } }
    __syncthreads();
    const int it = it0 + tid, bh = it / (B_D * 48), rem = it % (B_D * 48);
    const float* cf = coef + (bh - bh0) * 128;
    {
        u32x2* p = (u32x2*)((bf16_t*)(ws + WS_MDC) + (size_t)bh * 64 * B_D * B_D) + rem;
        f32x4 C = (f32x4){0.f, 0.f, 0.f, 0.f};
#pragma unroll 1
        for (int hb = 0; hb < 2; ++hb) {
            u32x2 x[32];
#pragma unroll
            for (int c = 0; c < 32; ++c) x[c] = p[(size_t)(32 * hb + c) * (B_D * B_D / 4)];
#pragma unroll
            for (int c = 0; c < 32; ++c) { const float aa = cf[2 * (32 * hb + c)], ww = cf[2 * (32 * hb + c) + 1];
                C.x = aa * C.x + ww * bf_lo(x[c].x); C.y = aa * C.y + ww * bf_hi(x[c].x); C.z = aa * C.z + ww * bf_lo(x[c].y); C.w = aa * C.w + ww * bf_hi(x[c].y);
                x[c].x = pk2(C.x, C.y); x[c].y = pk2(C.z, C.w); }
#pragma unroll
            for (int c = 0; c < 32; ++c) p[(size_t)(32 * hb + c) * (B_D * B_D / 4)] = x[c];
            asm volatile("" ::: "memory");
        }
    }
    if (rem < B_D) {
        float* pn = (float*)(ws + WS_MDN) + (size_t)bh * 64 * B_D + rem;
        float n = 0.f;
#pragma unroll 1
        for (int hb = 0; hb < 2; ++hb) {
            float xn[32];
#pragma unroll
            for (int c = 0; c < 32; ++c) xn[c] = pn[(32 * hb + c) * B_D];
#pragma unroll
            for (int c = 0; c < 32; ++c) { n = cf[2 * (32 * hb + c)] * n + cf[2 * (32 * hb + c) + 1] * xn[c]; xn[c] = n; }
#pragma unroll
            for (int c = 0; c < 32; ++c) pn[(32 * hb + c) * B_D] = xn[c];
            asm volatile("" ::: "memory");
        }
        if (rem < 64) ((float*)(ws + WS_MSC) + 1024)[bh * 64 + rem] = mns[(bh - bh0) * 64 + rem];
    }
}

__device__ __forceinline__ void mlstm_out_item(ArgsP a, const int tid, int layer, unsigned char* lds, int item) {
    const int lane = tid & 63, wave = __builtin_amdgcn_readfirstlane(tid >> 6);
    const int bh = item >> 6, c = item & 63, b = bh >> 2, h = bh & 3;
    const size_t tok0 = (size_t)b * SEQ + c * 64;
    bf16_t* QS = (bf16_t*)lds; bf16_t* KS = QS + 64 * MSTR; bf16_t* VS = KS + 64 * MSTR; bf16_t* PS = VS + 64 * MSTR;
    float* gA = (float*)(PS + 64 * PSTR); float* uA = gA + 64; float* winA = uA + 64; float* emtA = winA + 64; float* qnA = emtA + 64;
    float* RS = qnA + 64; float* SS = RS + 128; float* nprev = SS + 128;
    bf16_t* BS = (bf16_t*)(nprev + 192);
    unsigned char* ws = a->ws;
    const bf16_t* Z = (const bf16_t*)(ws + WS_Z);
    const float* gate = (const float*)(ws + WS_GATE);
    const float* MS = (const float*)(ws + WS_MSC) + 1024;
    __syncthreads();
    const float m_prev = (c > 0) ? MS[item - 1] : 0.f;
    if (wave == 0) {
        const float li = gate[(tok0 + lane) * 16 + 6 + h] + a->in[I_MIB][layer * B_H + h];
        const float lf = log_sigmoidf_(gate[(tok0 + lane) * 16 + 10 + h] + a->in[I_MFB][layer * B_H + h]);
        float bc = lf;
#pragma unroll
        for (int o = 1; o < 64; o <<= 1) { const float t = SHUP(bc, o); if (lane >= o) bc += t; }
        const float g = li - bc;
        float M = g;
#pragma unroll
        for (int o = 1; o < 64; o <<= 1) { const float t = SHUP(M, o); if (lane >= o) M = fmaxf(M, t); }
        const float u = fmaxf(m_prev, M);
        gA[lane] = g; uA[lane] = u; winA[lane] = __expf(m_prev - u); emtA[lane] = __expf(-(bc + u));
    }
    if (tid >= 64 && tid < 64 + B_D) nprev[tid - 64] = (c > 0) ? ((const float*)(ws + WS_MDN))[(size_t)(item - 1) * B_D + tid - 64] : 0.f;
    {
        const float* cwq = a->in[I_MCONVW] + (size_t)layer * 4 * 1536 + h * B_D;
#pragma unroll
        for (int o = 0; o < 3; ++o) {
            const int idx = tid + 512 * o, s = idx / 24, ch = (idx % 24) * 8, t = c * 64 + s;
            const bf16_t* zrow = Z + (tok0 + s) * ZLD;
            float qv[8]; conv8_silu(zrow, t, ZC_BQK + h * B_D + ch, cwq + ch, qv, c > 0);
            *(u32x4*)(QS + s * MSTR + ch) = pack8f(qv, 0.07216878364870322f);
            *(u32x4*)(KS + s * MSTR + ch) = *(const u32x4*)((const bf16_t*)(ws + WS_MKC) + ((size_t)item * 64 + s) * B_D + ch);
            *(u32x4*)(VS + s * MSTR + ch) = *(const u32x4*)(zrow + ZC_BV + h * B_D + ch);
            *(u32x4*)(BS + s * MSTR + ch) = *(const u32x4*)(zrow + ZC_BO + h * B_D + ch);
        }
    }
    __syncthreads();
    {
        const int t = tid >> 3, part = tid & 7; float acc = 0.f;
        { u32x4 qw[3]; f32x4 nv[6];
#pragma unroll
          for (int k = 0; k < 3; ++k) qw[k] = *(const u32x4*)(QS + t * MSTR + part * 24 + 8 * k);
#pragma unroll
          for (int k = 0; k < 6; ++k) nv[k] = *(const f32x4*)(nprev + part * 24 + 4 * k);
#pragma unroll
          for (int k = 0; k < 3; ++k) { float q8[8]; unpack8(qw[k], q8);
              acc += (q8[0] * nv[2 * k].x + q8[1] * nv[2 * k].y) + (q8[2] * nv[2 * k].z + q8[3] * nv[2 * k].w) + (q8[4] * nv[2 * k + 1].x + q8[5] * nv[2 * k + 1].y) + (q8[6] * nv[2 * k + 1].z + q8[7] * nv[2 * k + 1].w); } }
        acc += SHX(acc, 1); acc += SHX(acc, 2); acc += SHX(acc, 4);
        if (part == 0) qnA[t] = acc;
    }
    const int i16 = lane & 15, g4 = lane >> 4;
    const int r = wave & 3, hf = wave >> 2;
    {
        float rowp[4] = {0.f, 0.f, 0.f, 0.f};
#pragma unroll
        for (int ci = 0; ci < 2; ++ci) {
            const int ct = 2 * hf + ci;
            f32x4 acc = (f32x4){0.f, 0.f, 0.f, 0.f};
#pragma unroll
            for (int ks = 0; ks < 6; ++ks) {
                const bf16x8 A = *(const bf16x8*)(QS + (16 * r + i16) * MSTR + 32 * ks + 8 * g4);
                const bf16x8 B = *(const bf16x8*)(KS + (16 * ct + i16) * MSTR + 32 * ks + 8 * g4);
                acc = __builtin_amdgcn_mfma_f32_16x16x32_bf16(A, B, acc, 0, 0, 0);
            }
            const int s = 16 * ct + i16; const float gs = gA[s];
#pragma unroll
            for (int rg = 0; rg < 4; ++rg) { const int t = 16 * r + 4 * g4 + rg;
                const float val = (s <= t) ? acc[rg] * __expf(gs - uA[t]) : 0.f;
                PS[t * PSTR + s] = (bf16_t)f2bf(val); rowp[rg] += val; }
        }
#pragma unroll
        for (int rg = 0; rg < 4; ++rg) { float v = rowp[rg]; v += SHX(v, 1); v += SHX(v, 2); v += SHX(v, 4); v += SHX(v, 8);
            if (i16 == 0) RS[hf * 64 + 16 * r + 4 * g4 + rg] = v; }
    }
    __syncthreads();
    f32x4 acc[6];
#pragma unroll
    for (int j = 0; j < 6; ++j) acc[j] = (f32x4){0.f, 0.f, 0.f, 0.f};
    if (c > 0) {
        const bf16_t* CS = (const bf16_t*)(ws + WS_MDC) + (size_t)(item - 1) * B_D * B_D;
#pragma unroll
        for (int ks = 0; ks < 6; ++ks) {
            bf16x8 Bf[6];
#pragma unroll
            for (int j = 0; j < 6; ++j) Bf[j] = *(const bf16x8*)(CS + (size_t)(96 * hf + 16 * j + i16) * B_D + 32 * ks + 8 * g4);
            const bf16x8 A = *(const bf16x8*)(QS + (16 * r + i16) * MSTR + 32 * ks + 8 * g4);
#pragma unroll
            for (int j = 0; j < 6; ++j) acc[j] = __builtin_amdgcn_mfma_f32_16x16x32_bf16(A, Bf[j], acc[j], 0, 0, 0);
            asm volatile("" ::: "memory");
        }
#pragma unroll
        for (int rg = 0; rg < 4; ++rg) { const float wi = winA[16 * r + 4 * g4 + rg];
#pragma unroll
            for (int j = 0; j < 6; ++j) acc[j][rg] *= wi; }
    }
#pragma unroll
    for (int ks = 0; ks < 2; ++ks) {
        const bf16x8 A = *(const bf16x8*)(PS + (16 * r + i16) * PSTR + 32 * ks + 8 * g4);
        const int s0 = 32 * ks + 8 * g4 + (i16 >> 2), cc = 4 * (i16 & 3);
#pragma unroll
        for (int j = 0; j < 6; ++j) {
            const bf16x8 B = cat8(tr16(VS + s0 * MSTR + 96 * hf + 16 * j + cc), tr16(VS + (s0 + 4) * MSTR + 96 * hf + 16 * j + cc));
            acc[j] = __builtin_amdgcn_mfma_f32_16x16x32_bf16(A, B, acc[j], 0, 0, 0);
        }
    }
    float sq[4];
#pragma unroll
    for (int rg = 0; rg < 4; ++rg) { const int t = 16 * r + 4 * g4 + rg;
        const float den = winA[t] * qnA[t] + RS[t] + RS[64 + t];
        const float inv = 1.f / fmaxf(fabsf(den), emtA[t]);
        float s2 = 0.f;
#pragma unroll
        for (int j = 0; j < 6; ++j) { const int e = 96 * hf + 16 * j + i16;
            const float bo = bf2f(BS[t * MSTR + e]);
            const float yb = sigmoidf_(bo) * acc[j][rg] * inv; acc[j][rg] = yb; s2 += yb * yb; }
        s2 += SHX(s2, 1); s2 += SHX(s2, 2); s2 += SHX(s2, 4); s2 += SHX(s2, 8);
        sq[rg] = s2;
        if (i16 == 0) SS[hf * 64 + t] = s2; }
    __syncthreads();
    bf16_t* Y = (bf16_t*)(ws + WS_Y);
    const float* ong = a->in[I_ONG] + layer * DM + 768 + h * B_D;
    bf16_t* YS = QS;
#pragma unroll
    for (int rg = 0; rg < 4; ++rg) { const int t = 16 * r + 4 * g4 + rg;
        const float rr = rsqrtf((SS[t] + SS[64 + t]) * (1.f / B_D) + 1e-6f);
#pragma unroll
        for (int j = 0; j < 6; ++j) { const int e = 96 * hf + 16 * j + i16;
            YS[t * MSTR + e] = (bf16_t)f2bf(acc[j][rg] * rr * ong[e]); } }
    __syncthreads();
    { const int row = tid >> 3, c0 = (tid & 7) * 24;
#pragma unroll
      for (int q = 0; q < 3; ++q) *(u32x4*)(Y + (tok0 + row) * DM + 768 + h * B_D + c0 + 8 * q) = *(const u32x4*)(YS + row * MSTR + c0 + 8 * q); }
    (void)sq;
}
typedef float f32x16 __attribute__((ext_vector_type(16)));
constexpr int AKSTR = 136;
constexpr int ATT_KV_BYTES = 64 * AKSTR * 2;
constexpr int ATT_ITEMS = 12 * 32;
__device__ __forceinline__ void attn_item(ArgsP a, const int tid, int layer, unsigned char* lds, int bh, int qb) {
    const int lane = tid & 63, wave = __builtin_amdgcn_readfirstlane(tid >> 6), grp = wave >> 2, wq = wave & 3;
    const int b = bh / A_H, h = bh % A_H;
    const int l31 = lane & 31, hh = lane >> 5, i16 = lane & 15, g4 = lane >> 4;
    unsigned char* ws = a->ws;
    const bf16_t* Z = (const bf16_t*)(ws + WS_Z);
    const float* CF = (const float*)(ws + WS_CFOX) + (size_t)bh * SEQ;
    const size_t tokb = (size_t)b * SEQ;
    const int q0 = 128 * qb + 32 * wq;
    bf16_t* KS = (bf16_t*)lds;
    bf16_t* VS = (bf16_t*)(lds + 2 * ATT_KV_BYTES);
    float* CB = (float*)(lds + 4 * ATT_KV_BYTES);
    bf16_t* QS = (bf16_t*)(lds + 4 * ATT_KV_BYTES + 1024);
    const float C2 = 0.12751743f, LOG2E = 1.4426950408889634f;
    f32x16 O[4];
#pragma unroll
    for (int dt = 0; dt < 4; ++dt)
#pragma unroll
        for (int r = 0; r < 16; ++r) O[dt][r] = 0.f;
    float m = -1e30f, l = 0.f;
    u32x4 st[8]; float cbr = 0.f;
    const int srow0 = tid >> 4, sch = tid & 15;
    __syncthreads();
    if (grp == 0) { const bf16_t* qp = Z + (tokb + q0 + l31) * ZLD + ZC_AQ + h * A_D + 8 * hh;
#pragma unroll
      for (int ks = 0; ks < 8; ++ks) *(bf16x8*)(QS + (32 * wq + l31) * AKSTR + 16 * ks + 8 * hh) = *(const bf16x8*)(qp + 16 * ks); }
#define ATT_ISSUE(i) do { _Pragma("unroll") for (int tt = 0; tt < 2; ++tt) _Pragma("unroll") for (int rep = 0; rep < 2; ++rep) { \
        const bf16_t* p = Z + (tokb + 64 * (2 * (i) + tt) + srow0 + 32 * rep) * ZLD + h * A_D + 8 * sch; \
        st[tt * 4 + rep] = *(const u32x4*)(p + ZC_AK); st[tt * 4 + 2 + rep] = *(const u32x4*)(p + ZC_AV); } \
        if (tid < 128) cbr = -CF[64 * (2 * (i)) + tid] * LOG2E; } while (0)
#define ATT_WRITE_K(i) do { _Pragma("unroll") for (int tt = 0; tt < 2; ++tt) _Pragma("unroll") for (int rep = 0; rep < 2; ++rep) \
        *(u32x4*)(KS + tt * 64 * AKSTR + (srow0 + 32 * rep) * AKSTR + 8 * sch) = st[tt * 4 + rep]; \
        if (tid < 128) CB[((i) & 1) * 128 + tid] = cbr; } while (0)
#define ATT_WRITE_V() do { _Pragma("unroll") for (int tt = 0; tt < 2; ++tt) _Pragma("unroll") for (int rep = 0; rep < 2; ++rep) \
        *(u32x4*)(VS + tt * 64 * AKSTR + (srow0 + 32 * rep) * AKSTR + 8 * sch) = st[tt * 4 + 2 + rep]; } while (0)
    ATT_ISSUE(0); ATT_WRITE_K(0); ATT_WRITE_V();
    __syncthreads();
    const bf16_t* Kt = KS + grp * 64 * AKSTR; const bf16_t* Vt = VS + grp * 64 * AKSTR;
    for (int i = 0; i <= qb; ++i) {
        const float* cb = CB + (i & 1) * 128 + grp * 64;
        if (i < qb) ATT_ISSUE(i + 1);
        f32x16 s0, s1;
#pragma unroll
        for (int r = 0; r < 16; ++r) { s0[r] = 0.f; s1[r] = 0.f; }
#pragma unroll
        for (int ks = 0; ks < 8; ++ks) {
            const bf16x8 A0 = *(const bf16x8*)(Kt + l31 * AKSTR + 16 * ks + 8 * hh);
            const bf16x8 A1 = *(const bf16x8*)(Kt + (32 + l31) * AKSTR + 16 * ks + 8 * hh);
            const bf16x8 qk = *(const bf16x8*)(QS + (32 * wq + l31) * AKSTR + 16 * ks + 8 * hh);
            s0 = __builtin_amdgcn_mfma_f32_32x32x16_bf16(A0, qk, s0, 0, 0, 0);
            s1 = __builtin_amdgcn_mfma_f32_32x32x16_bf16(A1, qk, s1, 0, 0, 0);
        }
        __syncthreads();
        if (i < qb) ATT_WRITE_K(i + 1);
#pragma unroll
        for (int g = 0; g < 4; ++g) { const f32x4 c0 = *(const f32x4*)(cb + 8 * g + 4 * hh), c1 = *(const f32x4*)(cb + 32 + 8 * g + 4 * hh);
#pragma unroll
            for (int e = 0; e < 4; ++e) { s0[4 * g + e] = s0[4 * g + e] * C2 + c0[e]; s1[4 * g + e] = s1[4 * g + e] * C2 + c1[e]; } }
        if (i == qb) {
            const int dq = (q0 + l31) - (64 * (2 * i + grp) + 4 * hh);
#pragma unroll
            for (int r = 0; r < 16; ++r) { const int kr = (r & 3) + 8 * (r >> 2);
                if (kr > dq) s0[r] = -__builtin_inff();
                if (kr + 32 > dq) s1[r] = -__builtin_inff(); }
        }
        float mx = s0[0];
#pragma unroll
        for (int r = 1; r < 16; ++r) mx = fmaxf(mx, s0[r]);
#pragma unroll
        for (int r = 0; r < 16; ++r) mx = fmaxf(mx, s1[r]);
        mx = fmaxf(mx, SHX(mx, 32));
        const float mn = fmaxf(m, mx);
        const float alpha = __builtin_amdgcn_exp2f(m - mn);
        m = mn;
        float ls = 0.f;
#pragma unroll
        for (int r = 0; r < 16; ++r) { s0[r] = __builtin_amdgcn_exp2f(s0[r] - mn); s1[r] = __builtin_amdgcn_exp2f(s1[r] - mn); ls += s0[r] + s1[r]; }
        l = l * alpha + ls;
#pragma unroll
        for (int dt = 0; dt < 4; ++dt)
#pragma unroll
            for (int r = 0; r < 16; ++r) O[dt][r] *= alpha;
#pragma unroll
        for (int sub = 0; sub < 2; ++sub)
#pragma unroll
            for (int k2 = 0; k2 < 2; ++k2) {
                u32x4 pw;
                if (sub == 0) { pw.x = pg8::cvt_pk_bf16(s0[8 * k2 + 0], s0[8 * k2 + 1]); pw.y = pg8::cvt_pk_bf16(s0[8 * k2 + 2], s0[8 * k2 + 3]); pw.z = pg8::cvt_pk_bf16(s0[8 * k2 + 4], s0[8 * k2 + 5]); pw.w = pg8::cvt_pk_bf16(s0[8 * k2 + 6], s0[8 * k2 + 7]); }
                else          { pw.x = pg8::cvt_pk_bf16(s1[8 * k2 + 0], s1[8 * k2 + 1]); pw.y = pg8::cvt_pk_bf16(s1[8 * k2 + 2], s1[8 * k2 + 3]); pw.z = pg8::cvt_pk_bf16(s1[8 * k2 + 4], s1[8 * k2 + 5]); pw.w = pg8::cvt_pk_bf16(s1[8 * k2 + 6], s1[8 * k2 + 7]); }
                const bf16x8 P = __builtin_bit_cast(bf16x8, pw);
                const bf16_t* vb = Vt + (32 * sub + 16 * k2 + 4 * hh + (i16 >> 2)) * AKSTR + 16 * (g4 & 1) + 4 * (i16 & 3);
#pragma unroll
                for (int dt = 0; dt < 4; ++dt) {
                    const bf16x8 Av = cat8(tr16(vb + 32 * dt), tr16(vb + 8 * AKSTR + 32 * dt));
                    O[dt] = __builtin_amdgcn_mfma_f32_32x32x16_bf16(Av, P, O[dt], 0, 0, 0);
                }
            }
        __syncthreads();
        if (i < qb) ATT_WRITE_V();
    }
#undef ATT_ISSUE
#undef ATT_WRITE_K
#undef ATT_WRITE_V
    l += SHX(l, 32);
    float* MB = (float*)lds;
    float* ML = MB + 4 * 64 * 64;
    if (grp == 1) {
#pragma unroll
        for (int dt = 0; dt < 4; ++dt)
#pragma unroll
            for (int r = 0; r < 16; ++r) MB[(wq * 64 + dt * 16 + r) * 64 + lane] = O[dt][r];
        ML[(wq * 2) * 64 + lane] = m; ML[(wq * 2 + 1) * 64 + lane] = l;
    }
    __syncthreads();
    if (grp == 0) {
        const float m1 = ML[(wq * 2) * 64 + lane], l1 = ML[(wq * 2 + 1) * 64 + lane];
        const float mm = fmaxf(m, m1), w0 = __builtin_amdgcn_exp2f(m - mm), w1 = __builtin_amdgcn_exp2f(m1 - mm);
        const float inv = 1.f / (l * w0 + l1 * w1);
        float ss = 0.f;
#pragma unroll
        for (int dt = 0; dt < 4; ++dt)
#pragma unroll
            for (int r = 0; r < 16; ++r) { const float o = (O[dt][r] * w0 + MB[(wq * 64 + dt * 16 + r) * 64 + lane] * w1) * inv; O[dt][r] = o; ss += o * o; }
        ss += SHX(ss, 32);
        const float rr = rsqrtf(ss * (1.f / A_D) + 1e-6f);
        bf16_t* yp = (bf16_t*)(ws + WS_Y) + (tokb + q0 + l31) * DM + h * A_D;
        const float* ong = a->in[I_ONG] + layer * DM + h * A_D;
#pragma unroll
        for (int dt = 0; dt < 4; ++dt) {
            f32x4 gq[4];
#pragma unroll
            for (int g = 0; g < 4; ++g) gq[g] = *(const f32x4*)(ong + 32 * dt + 8 * g + 4 * hh);
#pragma unroll
            for (int g = 0; g < 4; ++g) { const int d = 32 * dt + 8 * g + 4 * hh; const f32x4 gg = gq[g];
                u32x2 w; w.x = pk2(O[dt][4 * g] * rr * gg.x, O[dt][4 * g + 1] * rr * gg.y); w.y = pk2(O[dt][4 * g + 2] * rr * gg.z, O[dt][4 * g + 3] * rr * gg.w);
                *(u32x2*)(yp + d) = w; } }
    }
}
__device__ __forceinline__ void conv_front_tile(ArgsP a, const int tid, int layer, unsigned char* lds, int tile) {
    const int lane = tid & 63, wave = tid >> 6;
    float* glu = (float*)lds;
    float* part = glu + 62 * 512;
    float* stat = part + 32 * 16;
    const bf16_t* Z = (const bf16_t*)(a->ws + WS_Z);
    bf16_t* CA = (bf16_t*)(a->ws + WS_CACT);
    const float* dw = a->in[I_CDWW] + (size_t)layer * C_K * C_W;
    float w[C_K];
#pragma unroll
    for (int j = 0; j < C_K; ++j) w[j] = dw[j * C_W + tid];
    const float db = a->in[I_CDWB][layer * C_W + tid], lg = a->in[I_CLNG][layer * C_W + tid], lb = a->in[I_CLNB][layer * C_W + tid];
    {
        const int tok0 = tile * 32, t0 = tok0 % SEQ;
        __syncthreads();
#pragma unroll
        for (int r0 = 0; r0 < 64; r0 += 16) {
            unsigned short xa[16], xg[16];
#pragma unroll
            for (int k = 0; k < 16; ++k) if (r0 + k < 62) { const int back = 30 - (r0 + k); const bf16_t* zp = Z + (size_t)(tok0 - (back <= t0 ? back : t0)) * ZLD;
                xa[k] = zp[ZC_CA + tid]; xg[k] = zp[ZC_CG + tid]; }
#pragma unroll
            for (int k = 0; k < 16; ++k) if (r0 + k < 62) { const int r = r0 + k;
                const float ca = bf2f(xa[k]), cg = bf2f(xg[k]);
                glu[r * 512 + tid] = (t0 - 30 + r >= 0) ? ca * sigmoidf_(cg) : 0.f; }
        }
        __syncthreads();
        float yc[32];
#pragma unroll
        for (int tt = 0; tt < 32; ++tt) { float acc = db;
#pragma unroll
            for (int j = 0; j < C_K; ++j) acc += w[j] * glu[(tt + j) * 512 + tid];
            yc[tt] = acc; }
        {
            float s1[32], s2[32];
#pragma unroll
            for (int tt = 0; tt < 32; ++tt) { s1[tt] = yc[tt]; s2[tt] = yc[tt] * yc[tt]; }
#define CF_STEP(o_) { _Pragma("unroll") for (int tt = 0; tt < 32; ++tt) { s1[tt] += SHX(s1[tt], o_); s2[tt] += SHX(s2[tt], o_); } asm volatile("" ::: "memory"); }
            CF_STEP(32) CF_STEP(16) CF_STEP(8) CF_STEP(4) CF_STEP(2) CF_STEP(1)
#undef CF_STEP
            if (lane == 0) {
#pragma unroll
                for (int tt = 0; tt < 32; ++tt) { part[(tt * 8 + wave) * 2] = s1[tt]; part[(tt * 8 + wave) * 2 + 1] = s2[tt]; } }
        }
        __syncthreads();
        if (tid < 32) { float s1 = 0.f, s2 = 0.f;
#pragma unroll
            for (int wv = 0; wv < 8; ++wv) { s1 += part[(tid * 8 + wv) * 2]; s2 += part[(tid * 8 + wv) * 2 + 1]; }
            const float mean = s1 * (1.f / C_W); const float var = fmaxf(s2 * (1.f / C_W) - mean * mean, 0.f);
            stat[tid * 2] = mean; stat[tid * 2 + 1] = rsqrtf(var + 1e-5f); }
        __syncthreads();
#pragma unroll
        for (int tt = 0; tt < 32; ++tt) { const float v = (yc[tt] - stat[tt * 2]) * stat[tt * 2 + 1] * lg + lb; CA[(size_t)(tok0 + tt) * C_W + tid] = (bf16_t)f2bf(v * sigmoidf_(v)); }
    }
}
__device__ __forceinline__ void phase_gates_b1(ArgsP a, const int tid, int layer, unsigned char* lds, int ngemm) {
    const int G = gridDim.x, blk = blockIdx.x;
    if (G >= ngemm + 64) {
        phase_gateprep(a, tid, layer, lds, blk - (G - 12));
        if (blk >= ngemm) for (int it = blk - ngemm; it < 512; it += G - ngemm) mlstm_b1_item(a, tid, layer, lds, it);
    } else {
        __syncthreads();
        phase_gateprep(a, tid, layer, lds, blk);
        for (int it = G - 1 - blk; it < 512; it += G) mlstm_b1_item(a, tid, layer, lds, it);
    }
}
__device__ __forceinline__ void phase_mixers(ArgsP a, const int tid, int layer, unsigned char* lds, int rep) {
    unsigned* head = (unsigned*)(a->ws + WS_CTL) + 8192 + 64 * (layer * 2 + rep);
    unsigned* slot = (unsigned*)(lds + MISC_OFF + 64);
    for (;;) {
        __syncthreads();
        if (tid == 0) *slot = atomicAdd(head, 1u);
        __syncthreads();
        int idx = (int)*slot;
        if (rep) idx += NSCAN;
        if (idx >= (rep ? NSCAN + ATT_ITEMS : NSCAN + ATT_ITEMS + NTOK / 32)) break;
        if (idx < NSCAN) mlstm_scan_piece(a, tid, lds, idx);
        else if (idx < NSCAN + ATT_ITEMS) attn_item(a, tid, layer, lds, (idx - NSCAN) % 12, 31 - (idx - NSCAN) / 12);
        else conv_front_tile(a, tid, layer, lds, idx - NSCAN - ATT_ITEMS);
    }
}
__device__ __forceinline__ void phase_mlstm_out(ArgsP a, const int tid, int layer, unsigned char* lds, int rep) {
    unsigned* head = (unsigned*)(a->ws + WS_CTL) + 8192 + 64 * (4 + layer * 2 + rep);
    unsigned* slot = (unsigned*)(lds + MISC_OFF + 64);
    for (;;) {
        __syncthreads();
        if (tid == 0) *slot = atomicAdd(head, 1u);
        __syncthreads();
        const int idx = (int)*slot;
        if (idx >= 512) break;
        mlstm_out_item(a, tid, layer, lds, idx);
    }
}

__device__ __forceinline__ void ycnorm_unit(ArgsP a, const int tid, int layer, int unit) {
    const int lane = tid & 63, wave = tid >> 6;
    pg8::StaticOrder S; S.init(NTOK, C_W, gridDim.x, unit); pg8::Unit u; if (!S.next(0, u)) return;
    const float* YC = (const float*)(a->ws + WS_YCR);
    bf16_t* Y = (bf16_t*)(a->ws + WS_Y);
    const float* ong = a->in[I_ONG] + layer * DM + 1536 + u.pn * 256;
    asm volatile("s_waitcnt vmcnt(0)" ::: "memory");
    __syncthreads();
    const f32x4 g = *(const f32x4*)(ong + lane * 4);
    for (int r0 = wave; r0 < 256; r0 += 64) {
        f32x4 v[8];
#pragma unroll
        for (int k = 0; k < 8; ++k) v[k] = *(const f32x4*)(YC + (size_t)(u.pm * 256 + r0 + 8 * k) * C_W + u.pn * 256 + lane * 4);
#pragma unroll
        for (int k = 0; k < 8; ++k) {
            const int tok = u.pm * 256 + r0 + 8 * k;
            float s = (v[k].x * v[k].x + v[k].y * v[k].y) + (v[k].z * v[k].z + v[k].w * v[k].w);
#pragma unroll
            for (int o = 16; o > 0; o >>= 1) s += SHX(s, o);
            const float r = rsqrtf(s * (1.f / 128.f) + 1e-6f);
            u32x2 w; w.x = pk2(v[k].x * r * g.x, v[k].y * r * g.y); w.y = pk2(v[k].z * r * g.z, v[k].w * r * g.w);
            *(u32x2*)(Y + (size_t)tok * DM + 1536 + u.pn * 256 + lane * 4) = w;
        }
    }
}
__device__ __forceinline__ float maxf3(float a, float b, float c) { return fmaxf(fmaxf(a, b), c); }
__device__ __forceinline__ unsigned fbits(float f) { return __builtin_bit_cast(unsigned, f); }
__device__ __forceinline__ float bitsf(unsigned u) { return __builtin_bit_cast(float, u); }
#define RT_CE(x_, y_) { const float hi_ = fmaxf(x_, y_), lo_ = fminf(x_, y_); x_ = hi_; y_ = lo_; }
#define RT_SORT_STEP(A_, k_, j_) _Pragma("unroll") for (int i_ = 0; i_ < 16; ++i_) { const int l_ = i_ ^ (j_); if (l_ > i_) { if ((i_ & (k_)) == 0) RT_CE(A_[i_], A_[l_]) else RT_CE(A_[l_], A_[i_]) } }
#define RT_SORT16(A_) RT_SORT_STEP(A_, 2, 1) RT_SORT_STEP(A_, 4, 2) RT_SORT_STEP(A_, 4, 1) RT_SORT_STEP(A_, 8, 4) RT_SORT_STEP(A_, 8, 2) RT_SORT_STEP(A_, 8, 1) RT_SORT_STEP(A_, 16, 8) RT_SORT_STEP(A_, 16, 4) RT_SORT_STEP(A_, 16, 2) RT_SORT_STEP(A_, 16, 1)
#define RT_BIT_STEP(A_, d_) _Pragma("unroll") for (int e_ = 0; e_ < 16; ++e_) if ((e_ & (d_)) == 0) RT_CE(A_[e_], A_[e_ + (d_)])
#define RT_MERGE16(O_, A_, B_) { _Pragma("unroll") for (int e_ = 0; e_ < 16; ++e_) O_[e_] = fmaxf(A_[e_], B_[15 - e_]); RT_BIT_STEP(O_, 8) RT_BIT_STEP(O_, 4) RT_BIT_STEP(O_, 2) RT_BIT_STEP(O_, 1) }
__device__ __forceinline__ void phase_peer_route(ArgsP a, const int tid, int layer, unsigned char* lds, const bool en) {
    const int lane = tid & 63, wave = __builtin_amdgcn_readfirstlane(tid >> 6);
    const int l31 = lane & 31, hh = lane >> 5;
    unsigned char* ws = a->ws;
    const float* Q = (const float*)(ws + WS_Q);
    const int h = blockIdx.x & 7, nb8 = gridDim.x >> 3;
    const bf16_t* KH = (const bf16_t*)(ws + WS_KH) + ((size_t)layer * P_H + h) * 2 * N_KEYS * 128;
    const bf16_t* KL = (const bf16_t*)(ws + WS_KL) + ((size_t)layer * P_H + h) * 2 * N_KEYS * 128;
    int* EI = (int*)(ws + WS_EIDX + layer * (8 * MiB)); float* EG = (float*)(ws + WS_EGATE + layer * (8 * MiB));
    unsigned char* tabI = lds + RT_TAB_OFF; unsigned char* tabJ = tabI + 64;
    unsigned char* myidx = tabI + 128 + ((wave & 3) * 64 + lane) * 32;
    const float NEG = -__builtin_inff();
    __syncthreads();
    if (tid == 0) { int n16 = 16; asm volatile("" : "+s"(n16));
        int k = 0;
#pragma unroll 1
        for (int i = 0; i < n16; ++i)
#pragma unroll 1
            for (int j = 0; j < n16; ++j) if ((i + 1) * (j + 1) <= n16) { tabI[k] = (unsigned char)i; tabJ[k] = (unsigned char)j; ++k; } }
    { const int r4 = lane >> 4, p = lane & 15;
#pragma unroll
      for (int q = 0; q < 16; ++q) { const int seg = wave * 16 + q;
          const int blkq = seg >> 5, r = (seg & 31) * 4 + r4;
          const bf16_t* src = ((blkq & 1) ? KL : KH) + ((size_t)(blkq >> 1) * N_KEYS + r) * 128 + ((p ^ (r & 15)) << 3);
          __builtin_amdgcn_global_load_lds((const unsigned*)src, (LAS unsigned*)((LAS unsigned char*)lds + seg * 1024), 16, 0, 0); } }
    asm volatile("s_waitcnt vmcnt(0)" ::: "memory");
    __syncthreads();
    if (wave >= 4) return;
    const LAS unsigned char* kl0 = (const LAS unsigned char*)lds + l31 * 256;
    const int sw = l31 & 15;
    for (int tb = (blockIdx.x >> 3) * 4 + wave; tb < (en ? NTOK / 32 : 0); tb += nb8 * 4) {
        const int tok = tb * 32 + l31;
        const float* qrow = Q + (size_t)tok * DM + h * 256;
        float V[2][16];
#pragma unroll
        for (int c = 0; c < 2; ++c) {
            f32x4 xq[16];
#pragma unroll
            for (int p = 0; p < 16; ++p) xq[p] = *(const f32x4*)(qrow + c * 128 + 16 * (p >> 1) + 8 * hh + 4 * (p & 1));
            f32x16 acc[4];
#pragma unroll
            for (int t4 = 0; t4 < 4; ++t4)
#pragma unroll
                for (int r = 0; r < 16; ++r) acc[t4][r] = 0.f;
#pragma unroll
            for (int ks = 0; ks < 8; ++ks) {
                const f32x4 x0 = xq[2 * ks], x1 = xq[2 * ks + 1];
                const unsigned h0 = f2bf(x0.x), h1 = f2bf(x0.y), h2 = f2bf(x0.z), h3 = f2bf(x0.w), h4 = f2bf(x1.x), h5 = f2bf(x1.y), h6 = f2bf(x1.z), h7 = f2bf(x1.w);
                u32x4 qhw, qlw;
                qhw.x = h0 | (h1 << 16); qhw.y = h2 | (h3 << 16); qhw.z = h4 | (h5 << 16); qhw.w = h6 | (h7 << 16);
                qlw.x = pk2(x0.x - bf_lo(h0), x0.y - bf_lo(h1)); qlw.y = pk2(x0.z - bf_lo(h2), x0.w - bf_lo(h3)); qlw.z = pk2(x1.x - bf_lo(h4), x1.y - bf_lo(h5)); qlw.w = pk2(x1.z - bf_lo(h6), x1.w - bf_lo(h7));
                const bf16x8 qh = __builtin_bit_cast(bf16x8, qhw), ql = __builtin_bit_cast(bf16x8, qlw);
                const int pos = ((2 * ks + hh) ^ sw) << 4;
#pragma unroll
                for (int t4 = 0; t4 < 4; ++t4) {
                    const bf16x8 kh = *(const LAS bf16x8*)(kl0 + (c * 2) * 32768 + t4 * 8192 + pos), kl = *(const LAS bf16x8*)(kl0 + (c * 2 + 1) * 32768 + t4 * 8192 + pos);
                    acc[t4] = __builtin_amdgcn_mfma_f32_32x32x16_bf16(kh, qh, acc[t4], 0, 0, 0);
                    acc[t4] = __builtin_amdgcn_mfma_f32_32x32x16_bf16(kh, ql, acc[t4], 0, 0, 0);
                    acc[t4] = __builtin_amdgcn_mfma_f32_32x32x16_bf16(kl, qh, acc[t4], 0, 0, 0);
                }
            }
#pragma unroll
            for (int t4 = 0; t4 < 4; ++t4)
#pragma unroll
                for (int r = 0; r < 16; ++r) { const unsigned key = 32 * t4 + (r & 3) + 8 * (r >> 2) + 4 * hh;
                    const float av = acc[t4][r]; acc[t4][r] = bitsf((fbits(av) & 0xFFFFFF80u) | key); }
            float top[16];
            { float s0[16], s1[16], s2[16], s3[16], m01[16], m23[16];
#pragma unroll
              for (int r = 0; r < 16; ++r) { s0[r] = acc[0][r]; s1[r] = acc[1][r]; s2[r] = acc[2][r]; s3[r] = acc[3][r]; }
              RT_SORT16(s0) RT_SORT16(s1) RT_SORT16(s2) RT_SORT16(s3)
              RT_MERGE16(m01, s0, s1) RT_MERGE16(m23, s2, s3) RT_MERGE16(top, m01, m23) }
            float cm[16];
#pragma unroll
            for (int e = 0; e < 16; ++e) cm[e] = SHX(top[e], 32);
#pragma unroll
            for (int e = 0; e < 16; ++e) V[c][e] = fmaxf(top[e], cm[15 - e]);
#define BITONIC_STEP(d) _Pragma("unroll") for (int e = 0; e < 16; ++e) if ((e & (d)) == 0) { const float hi = fmaxf(V[c][e], V[c][e + (d)]), lo = fminf(V[c][e], V[c][e + (d)]); V[c][e] = hi; V[c][e + (d)] = lo; }
            BITONIC_STEP(8) BITONIC_STEP(4) BITONIC_STEP(2) BITONIC_STEP(1)
#undef BITONIC_STEP
#pragma unroll
            for (int e = 0; e < 16; ++e) myidx[c * 16 + e] = (unsigned char)(__builtin_bit_cast(unsigned, V[c][e]) & 127u);
        }
        float sel[16];
        { float c0[16], c1[16], c2[16], c3[16], m01[16], m23[16];
#pragma unroll
          for (int r = 0; r < 16; ++r) { c0[r] = NEG; c1[r] = NEG; c2[r] = NEG; c3[r] = NEG; }
          { int k = 0;
#pragma unroll
            for (int i = 0; i < 16; ++i)
#pragma unroll
              for (int j = 0; j < 16; ++j) if ((i + 1) * (j + 1) <= 16) {
                  const float s = __builtin_bit_cast(float, __builtin_bit_cast(unsigned, V[0][i]) & 0xFFFFFF80u) + __builtin_bit_cast(float, __builtin_bit_cast(unsigned, V[1][j]) & 0xFFFFFF80u);
                  const float cv = __builtin_bit_cast(float, (__builtin_bit_cast(unsigned, s) & 0xFFFFFFC0u) | (unsigned)k);
                  if (k < 16) c0[k & 15] = cv; else if (k < 32) c1[k & 15] = cv; else if (k < 48) c2[k & 15] = cv; else c3[k & 15] = cv;
                  ++k; } }
          RT_SORT16(c0) RT_SORT16(c1) RT_SORT16(c2) RT_SORT16(c3)
          RT_MERGE16(m01, c0, c1) RT_MERGE16(m23, c2, c3) RT_MERGE16(sel, m01, m23) }
        LDS_FENCE();
        const float mx = __builtin_bit_cast(float, __builtin_bit_cast(unsigned, sel[0]) & 0xFFFFFFC0u);
        float ex[16], sum = 0.f; int eid[16];
#pragma unroll
        for (int e = 0; e < 16; ++e) { const unsigned bits = __builtin_bit_cast(unsigned, sel[e]); const int k = bits & 63u;
            ex[e] = __expf(__builtin_bit_cast(float, bits & 0xFFFFFFC0u) - mx); sum += ex[e];
            eid[e] = (int)myidx[tabI[k]] * N_KEYS + (int)myidx[16 + tabJ[k]]; }
        const float inv = 1.f / sum;
        int* eo = EI + (size_t)tok * 128 + h * P_TOPK + 8 * hh; float* go = EG + (size_t)tok * 128 + h * P_TOPK + 8 * hh;
        if (hh == 0) {
#pragma unroll
            for (int e = 0; e < 8; ++e) { eo[e] = eid[e]; go[e] = ex[e] * inv; }
        } else {
#pragma unroll
            for (int e = 0; e < 8; ++e) { eo[e] = eid[8 + e]; go[e] = ex[8 + e] * inv; }
        }
        LDS_FENCE();
    }
}

constexpr size_t LSTRIDE = 116 * MiB;
constexpr size_t WS_PU = 576 * MiB;
constexpr size_t WS_PV = 608 * MiB;
constexpr size_t WS_PS = 640 * MiB;
constexpr size_t WS_XQ = 641 * MiB;
constexpr size_t WS_SX = 657 * MiB;
constexpr size_t WS_PA = 658 * MiB;
constexpr size_t WS_EGU = 434 * MiB;
constexpr size_t WS_SW = 690 * MiB + 512 * 1024;
constexpr size_t WS_EWQ = 691 * MiB;
constexpr size_t WS_SSQ = 690 * MiB;
constexpr int PEER_GRP = 256;
__device__ __forceinline__ int xsum16(int v) { const auto r = __builtin_amdgcn_permlane16_swap((unsigned)v, (unsigned)v, false, false); return (int)(r[0] + r[1]); }
__device__ __forceinline__ int xsum32(int v) { const auto r = __builtin_amdgcn_permlane32_swap((unsigned)v, (unsigned)v, false, false); return (int)(r[0] + r[1]); }
__device__ __forceinline__ float rowsum16_dpp(float v) {
#define RS_STEP(c_) v += __builtin_bit_cast(float, __builtin_amdgcn_update_dpp(0, __builtin_bit_cast(int, v), c_, 0xf, 0xf, true));
    RS_STEP(0x111) RS_STEP(0x112) RS_STEP(0x114) RS_STEP(0x118)
#undef RS_STEP
    return v;
}
__device__ __forceinline__ float gelu_exact(float x) { return 0.5f * x * (1.f + erff(x * 0.70710678118654752f)); }
__device__ __forceinline__ float ub0(unsigned w) { return (float)(w & 0xffu); }
__device__ __forceinline__ float ub1(unsigned w) { return (float)((w >> 8) & 0xffu); }
__device__ __forceinline__ float ub2(unsigned w) { return (float)((w >> 16) & 0xffu); }
__device__ __forceinline__ float ub3(unsigned w) { return (float)(w >> 24); }
__device__ __forceinline__ unsigned q4(float a, float b, float c, float d, float inv, int bias) {
    const int qa = (int)rintf(a * inv) + bias, qb = (int)rintf(b * inv) + bias, qc = (int)rintf(c * inv) + bias, qd = (int)rintf(d * inv) + bias;
    return (unsigned)(qa & 0xff) | ((unsigned)(qb & 0xff) << 8) | ((unsigned)(qc & 0xff) << 16) | ((unsigned)(qd & 0xff) << 24);
}
constexpr int CONV_SPLIT = 26;
__device__ __forceinline__ void peer_convert_tables(ArgsP a, int layer, const int tid, const int k_lo, const int k_hi) {
    const int lane = tid & 63, wave = (tid >> 6) & 3;
    const int gw = blockIdx.x * 4 + wave, NGW = gridDim.x * 4;
    unsigned char* ws = a->ws;
    float* PS = (float*)(ws + WS_PS + layer * LSTRIDE);
    const int nk = (2 * N_EXP + NGW - 1) / NGW;
    for (int k = k_lo * nk / 32; k < k_hi * nk / 32; ++k) { const int row = gw + k * NGW; if (row >= 2 * N_EXP) break;
        const int tb = row & 1, e = row >> 1;
        const f32x4* src = (const f32x4*)((tb ? a->in[I_PV] : a->in[I_PU]) + ((size_t)layer * N_EXP + e) * DM);
        f32x4 x[8]; float am = 0.f;
#pragma unroll
        for (int j = 0; j < 2; ++j)
#pragma unroll
            for (int q = 0; q < 4; ++q) { const f32x4 v = src[4 * (lane + 64 * j) + q]; x[j * 4 + q] = v; am = fmaxf(fmaxf(am, fmaxf(fabsf(v.x), fabsf(v.y))), fmaxf(fabsf(v.z), fabsf(v.w))); }
        am = wave_max(am, lane);
        const float inv = am > 0.f ? 127.f / am : 0.f;
        unsigned char* dstb = ws + (tb ? WS_PV : WS_PU) + layer * LSTRIDE;
        const int bias = 0;
#pragma unroll
        for (int j = 0; j < 2; ++j) { u32x4 w; const int idx = lane + 64 * j;
            w.x = q4(x[j * 4].x, x[j * 4].y, x[j * 4].z, x[j * 4].w, inv, bias); w.y = q4(x[j * 4 + 1].x, x[j * 4 + 1].y, x[j * 4 + 1].z, x[j * 4 + 1].w, inv, bias);
            w.z = q4(x[j * 4 + 2].x, x[j * 4 + 2].y, x[j * 4 + 2].z, x[j * 4 + 2].w, inv, bias); w.w = q4(x[j * 4 + 3].x, x[j * 4 + 3].y, x[j * 4 + 3].z, x[j * 4 + 3].w, inv, bias);
            *(u32x4*)(dstb + ((size_t)(idx >> 4) * N_EXP + e) * 256 + 16 * (idx & 15)) = w; }
        if (lane == 0) PS[tb * N_EXP + e] = am * (1.f / 127.f);
    }
}
__device__ __forceinline__ void peer_quant_tokens(ArgsP a, int layer, const int tid) {
    const int lane = tid & 63, wave = (tid >> 6) - 4;
    const int gw = blockIdx.x * 4 + wave, NGW = gridDim.x * 4;
    unsigned char* ws = a->ws;
    const bf16_t* HN = (const bf16_t*)(ws + WS_HN);
    const float* P2 = (const float*)(ws + WS_P2);
    for (int t0 = gw; t0 < NTOK; t0 += 4 * NGW) {
        u32x4 hw[4][4]; float pp[4];
#pragma unroll
        for (int r = 0; r < 4; ++r) { const int tok = t0 + r * NGW; if (tok < NTOK) {
            pp[r] = P2[(size_t)(lane & 31) * NTOK + tok];
#pragma unroll
            for (int j = 0; j < 2; ++j)
#pragma unroll
                for (int q = 0; q < 2; ++q) hw[r][j * 2 + q] = ((const u32x4*)(HN + (size_t)tok * DM))[2 * (lane + 64 * j) + q]; } }
#pragma unroll
        for (int r = 0; r < 4; ++r) { const int tok = t0 + r * NGW; if (tok < NTOK) {
            float xf[32]; float am = 0.f;
#pragma unroll
            for (int c = 0; c < 4; ++c) { const u32x4 w = hw[r][c]; float* f = xf + c * 8;
                f[0] = bf_lo(w.x); f[1] = bf_hi(w.x); f[2] = bf_lo(w.y); f[3] = bf_hi(w.y); f[4] = bf_lo(w.z); f[5] = bf_hi(w.z); f[6] = bf_lo(w.w); f[7] = bf_hi(w.w); }
#pragma unroll
            for (int i = 0; i < 32; ++i) am = fmaxf(am, fabsf(xf[i]));
            am = wave_max(am, lane);
            const float rs = rsqrtf(wave_sum(lane < 32 ? pp[r] : 0.f, lane) * (1.f / DM) + 1e-6f);
            const float inv = am > 0.f ? 127.f / am : 0.f;
#pragma unroll
            for (int j = 0; j < 2; ++j) { u32x4 w; const float* f = xf + 16 * j;
                w.x = q4(f[0], f[1], f[2], f[3], inv, 0); w.y = q4(f[4], f[5], f[6], f[7], inv, 0); w.z = q4(f[8], f[9], f[10], f[11], inv, 0); w.w = q4(f[12], f[13], f[14], f[15], inv, 0);
                ((u32x4*)(ws + WS_XQ + layer * LSTRIDE + (size_t)tok * DM))[lane + 64 * j] = w; }
            if (lane == 0) ((float*)(ws + WS_SX + layer * LSTRIDE))[tok] = am * rs * (1.f / 127.f); } }
    }
}
__device__ __forceinline__ bool peer_pull(unsigned* heads, unsigned* slot, const int tid, int& cur, const int mine, int& slice, int& grp) {
    for (;;) {
        if (cur >= 8) return false;
        const int s = (mine + cur) & 7;
        __syncthreads();
        if (tid == 0) slot[0] = atomicAdd(heads + 64 * s, 1u);
        __syncthreads();
        const unsigned idx = slot[0];
        if (idx < (unsigned)(NTOK / PEER_GRP)) { slice = s; grp = (int)idx; return true; }
        ++cur;
    }
}
__device__ __forceinline__ void phase_peer_u(ArgsP a, const int tid, int layer, unsigned char* lds, int rep) {
    const int lane = tid & 63, wave = __builtin_amdgcn_readfirstlane(tid >> 6);
    const int g = lane >> 4, i = lane & 15;
    unsigned char* ws = a->ws;
    unsigned* heads = (unsigned*)(ws + WS_CTL) + 8192 + 64 * (8 + 16 * layer + 32 * rep);
    unsigned* slot = (unsigned*)(lds + MISC_OFF + 64);
    int* idsb = (int*)lds + wave * 256;
    const int* EI = (const int*)(ws + WS_EIDX + layer * (8 * MiB));
    const bool b3 = i & 8, b2 = i & 4, b1 = i & 2, b0 = i & 1;
    int cur = 0, slice, grp; const int mine = (int)xb_xcc_id() & 7;
#define PU_LOADH(buf, idp, h) do { _Pragma("unroll") for (int k_ = 0; k_ < 16; ++k_) buf[k_] = *(const u32x4*)(UT + (size_t)(idp)[32 * g + 16 * (h) + k_] * 256); } while (0)
#define PU_REDH(buf, xq_, out_) do { int d_[16]; _Pragma("unroll") for (int k_ = 0; k_ < 16; ++k_) { const u32x4 w_ = buf[k_]; \
            int c_ = __builtin_amdgcn_sdot4((int)w_.x, (int)(xq_).x, 0, false); c_ = __builtin_amdgcn_sdot4((int)w_.y, (int)(xq_).y, c_, false); c_ = __builtin_amdgcn_sdot4((int)w_.z, (int)(xq_).z, c_, false); d_[k_] = __builtin_amdgcn_sdot4((int)w_.w, (int)(xq_).w, c_, false); } \
        int v8_[8], v4_[4], v2_[2]; \
        _Pragma("unroll") for (int k_ = 0; k_ < 8; ++k_) { const int keep_ = b3 ? d_[k_ + 8] : d_[k_], send_ = b3 ? d_[k_] : d_[k_ + 8]; v8_[k_] = keep_ + SHXI(send_, 8); } \
        _Pragma("unroll") for (int k_ = 0; k_ < 4; ++k_) { const int keep_ = b2 ? v8_[k_ + 4] : v8_[k_], send_ = b2 ? v8_[k_] : v8_[k_ + 4]; v4_[k_] = keep_ + SHXI(send_, 4); } \
        _Pragma("unroll") for (int k_ = 0; k_ < 2; ++k_) { const int keep_ = b1 ? v4_[k_ + 2] : v4_[k_], send_ = b1 ? v4_[k_] : v4_[k_ + 2]; v2_[k_] = keep_ + SHXI(send_, 2); } \
        const int keep1_ = b0 ? v2_[1] : v2_[0], send1_ = b0 ? v2_[0] : v2_[1]; out_ = keep1_ + SHXI(send1_, 1); } while (0)
    while (peer_pull(heads, slot, tid, cur, mine, slice, grp)) {
        const unsigned char* UT = ws + WS_PU + layer * LSTRIDE + (size_t)slice * N_EXP * 256 + 16 * i;
        int* PA = (int*)(ws + WS_PA + layer * LSTRIDE) + (size_t)slice * NTOK * 128;
        const int tok0 = grp * PEER_GRP + wave * (PEER_GRP / 8);
        const unsigned char* xqp = ws + WS_XQ + layer * LSTRIDE + (size_t)tok0 * DM + 256 * slice + 16 * i;
        u32x4 bA[16], bB[16];
        u32x4 xq = *(const u32x4*)xqp, xqn = xq; int e0n = 0, e1n = 0;
        idsb[lane] = EI[(size_t)tok0 * 128 + lane]; idsb[64 + lane] = EI[(size_t)tok0 * 128 + 64 + lane];
        LDS_FENCE();
        PU_LOADH(bA, idsb, 0);
#pragma unroll 1
        for (int tt = 0; tt < PEER_GRP / 8; ++tt) {
            const int tok = tok0 + tt; const bool more = tt + 1 < PEER_GRP / 8;
            int* idc = idsb + (tt & 1) * 128; int* idn = idsb + ((tt + 1) & 1) * 128;
            if (more) { e0n = EI[(size_t)(tok + 1) * 128 + lane]; e1n = EI[(size_t)(tok + 1) * 128 + 64 + lane]; xqn = *(const u32x4*)(xqp + (size_t)(tt + 1) * DM); }
            PU_LOADH(bB, idc, 1);
            int r0, r1;
            PU_REDH(bA, xq, r0);
            if (more) { idn[lane] = e0n; idn[64 + lane] = e1n; LDS_FENCE(); PU_LOADH(bA, idn, 0); }
            PU_REDH(bB, xq, r1);
            PA[(size_t)tok * 128 + 32 * g + i] = r0; PA[(size_t)tok * 128 + 32 * g + 16 + i] = r1;
            xq = xqn;
        }
        LDS_FENCE();
    }
#undef PU_LOADH
#undef PU_REDH
}
__device__ __forceinline__ void phase_peer_a(ArgsP a, const int tid, int layer, unsigned char* lds) {
    const int lane = tid & 63, wave = tid >> 6;
    const int gw = blockIdx.x * 8 + wave, NGW = gridDim.x * 8;
    unsigned char* ws = a->ws;
    const float* EG = (const float*)(ws + WS_EGATE + layer * (8 * MiB)); const int* EI = (const int*)(ws + WS_EIDX + layer * (8 * MiB));
    const float* SU = (const float*)(ws + WS_PS + layer * LSTRIDE); const float* SV = SU + N_EXP;
    const float* SX = (const float*)(ws + WS_SX + layer * LSTRIDE); const int* PA = (const int*)(ws + WS_PA + layer * LSTRIDE);
    unsigned* WQ = (unsigned*)(ws + WS_EWQ + layer * LSTRIDE); float* SW = (float*)(ws + WS_SW + layer * LSTRIDE);
    unsigned char* wb = lds + wave * 128;
    for (int t0 = gw; t0 < NTOK; t0 += 4 * NGW) {
        int pa0[4][8], pa1[4][8], e0[4], e1[4]; float g0[4], g1[4], sx[4];
#pragma unroll
        for (int r = 0; r < 4; ++r) { const int tok = t0 + r * NGW; if (tok < NTOK) {
            e0[r] = EI[(size_t)tok * 128 + lane]; e1[r] = EI[(size_t)tok * 128 + 64 + lane]; g0[r] = EG[(size_t)tok * 128 + lane]; g1[r] = EG[(size_t)tok * 128 + 64 + lane]; sx[r] = SX[tok];
#pragma unroll
            for (int s = 0; s < 8; ++s) { pa0[r][s] = PA[((size_t)s * NTOK + tok) * 128 + lane]; pa1[r][s] = PA[((size_t)s * NTOK + tok) * 128 + 64 + lane]; } } }
        float su0[4], su1[4], sv0[4], sv1[4];
#pragma unroll
        for (int r = 0; r < 4; ++r) { const int tok = t0 + r * NGW; if (tok < NTOK) { su0[r] = SU[e0[r]]; su1[r] = SU[e1[r]]; sv0[r] = SV[e0[r]]; sv1[r] = SV[e1[r]]; } }
#pragma unroll
        for (int r = 0; r < 4; ++r) { const int tok = t0 + r * NGW; if (tok < NTOK) {
            int p0 = 0, p1 = 0;
#pragma unroll
            for (int s = 0; s < 8; ++s) { p0 += pa0[r][s]; p1 += pa1[r][s]; }
            const float w0 = gelu_exact((float)p0 * su0[r] * sx[r]) * g0[r] * sv0[r];
            const float w1 = gelu_exact((float)p1 * su1[r] * sx[r]) * g1[r] * sv1[r];
            const float am = wave_max(fmaxf(fabsf(w0), fabsf(w1)), lane);
            const float inv = am > 0.f ? 127.f / am : 0.f;
            wb[lane] = (unsigned char)((int)rintf(w0 * inv) & 0xff); wb[64 + lane] = (unsigned char)((int)rintf(w1 * inv) & 0xff);
            LDS_FENCE();
            if (lane < 32) WQ[(size_t)tok * 32 + lane] = ((const unsigned*)wb)[lane];
            if (lane == 0) SW[tok] = am * (1.f / 127.f);
            LDS_FENCE(); } }
    }
}
__device__ __forceinline__ void phase_peer_v(ArgsP a, const int tid, int layer, unsigned char* lds) {
    const int lane = tid & 63, wave = __builtin_amdgcn_readfirstlane(tid >> 6);
    const int g = lane >> 4, i = lane & 15;
    unsigned char* ws = a->ws;
    unsigned* heads = (unsigned*)(ws + WS_CTL) + 8192 + 64 * (16 + 16 * layer);
    unsigned* slot = (unsigned*)(lds + MISC_OFF + 64);
    int* idsb = (int*)lds + wave * 512;
    const int* EI = (const int*)(ws + WS_EIDX + layer * (8 * MiB));
    const unsigned* WQ = (const unsigned*)(ws + WS_EWQ + layer * LSTRIDE); const float* SW = (const float*)(ws + WS_SW + layer * LSTRIDE);
    float* X = (float*)(ws + WS_X);
    float* SSQ = (float*)(ws + WS_SSQ + layer * LSTRIDE);
    bf16_t* HNo = (bf16_t*)(ws + WS_HN);
    int cur = 0, slice, grp; const int mine = (int)xb_xcc_id() & 7;
    constexpr int NT = PEER_GRP / 8;
    unsigned i16v = 16u * (unsigned)i;
#define PV_PIN() asm volatile("" : "+v"(i16v) : "v"(acc[0]), "v"(acc[1]), "v"(acc[2]), "v"(acc[3]), "v"(acc[4]), "v"(acc[5]), "v"(acc[6]), "v"(acc[7]), "v"(acc[8]), "v"(acc[9]), "v"(acc[10]), "v"(acc[11]), "v"(acc[12]), "v"(acc[13]), "v"(acc[14]), "v"(acc[15]) : "memory")
#define PV_ISSUE(q_, idp_) do { _Pragma("unroll") for (int b_ = 0; b_ < 8; ++b_) { const unsigned off_ = ((unsigned)(idp_)[32 * g + 8 * (q_) + b_] << 8) + i16v; vall[8 * (q_) + b_] = *(const u32x4*)(VTs + off_); } } while (0)
#define PV_Q(q_, A_, B_, C_, D_) do { const unsigned x0_ = __builtin_amdgcn_perm(B_, A_, 0x05010400u), x1_ = __builtin_amdgcn_perm(B_, A_, 0x07030602u), y0_ = __builtin_amdgcn_perm(D_, C_, 0x05010400u), y1_ = __builtin_amdgcn_perm(D_, C_, 0x07030602u); \
                        acc[4 * (q_) + 0] = __builtin_amdgcn_sdot4((int)__builtin_amdgcn_perm(y0_, x0_, 0x05040100u), wq_, acc[4 * (q_) + 0], false); \
                        acc[4 * (q_) + 1] = __builtin_amdgcn_sdot4((int)__builtin_amdgcn_perm(y0_, x0_, 0x07060302u), wq_, acc[4 * (q_) + 1], false); \
                        acc[4 * (q_) + 2] = __builtin_amdgcn_sdot4((int)__builtin_amdgcn_perm(y1_, x1_, 0x05040100u), wq_, acc[4 * (q_) + 2], false); \
                        acc[4 * (q_) + 3] = __builtin_amdgcn_sdot4((int)__builtin_amdgcn_perm(y1_, x1_, 0x07060302u), wq_, acc[4 * (q_) + 3], false); } while (0)
#define PV_COMP(q_, wp_) do { _Pragma("unroll") for (int m_ = 0; m_ < 2; ++m_) { const int wq_ = (int)(wp_)[8 * g + 2 * (q_) + m_]; \
                        const u32x4 ra = vall[8 * (q_) + 4 * m_], rb = vall[8 * (q_) + 4 * m_ + 1], rc = vall[8 * (q_) + 4 * m_ + 2], rd = vall[8 * (q_) + 4 * m_ + 3]; \
                        PV_Q(0, ra.x, rb.x, rc.x, rd.x); PV_Q(1, ra.y, rb.y, rc.y, rd.y); PV_Q(2, ra.z, rb.z, rc.z, rd.z); PV_Q(3, ra.w, rb.w, rc.w, rd.w); } } while (0)
#define PV_TOKEN(MORE_) do { \
            const int tok = tok0 + tt; \
            int* idn = idsb + ((tt + 1) & 1) * 128; const unsigned* wqc = (const unsigned*)(idsb + 256 + (tt & 1) * 32); \
            const float swnx = swn; \
            if (MORE_) { idn[lane] = e0n; idn[64 + lane] = e1n; if (lane < 32) ((unsigned*)(idsb + 256 + ((tt + 1) & 1) * 32))[lane] = wqn; LDS_FENCE(); \
                if (tt + 2 < NT) { e0n = EI[(size_t)(tok + 2) * 128 + lane]; e1n = EI[(size_t)(tok + 2) * 128 + 64 + lane]; wqn = (lane < 32) ? WQ[(size_t)(tok + 2) * 32 + lane] : 0u; swn = SW[tok + 2]; } } \
            int acc[16]; \
            _Pragma("unroll") for (int c = 0; c < 16; ++c) acc[c] = 0; \
            PV_COMP(0, wqc); PV_PIN(); if (MORE_) PV_ISSUE(0, idn); asm volatile("" ::: "memory"); \
            PV_COMP(1, wqc); PV_PIN(); if (MORE_) PV_ISSUE(1, idn); asm volatile("" ::: "memory"); \
            PV_COMP(2, wqc); PV_PIN(); if (MORE_) PV_ISSUE(2, idn); asm volatile("" ::: "memory"); \
            PV_COMP(3, wqc); PV_PIN(); if (MORE_) PV_ISSUE(3, idn); asm volatile("" ::: "memory"); \
              \
            f32x4* xp = (f32x4*)(X + (size_t)tok * DM + 256 * slice + 16 * i); \
            float ss = 0.f; \
            _Pragma("unroll") for (int q = 0; q < 4; ++q) { \
                int t0 = acc[4 * q], t1 = acc[4 * q + 1], t2 = acc[4 * q + 2], t3 = acc[4 * q + 3]; \
                t0 = xsum32(xsum16(t0)); t1 = xsum32(xsum16(t1)); t2 = xsum32(xsum16(t2)); t3 = xsum32(xsum16(t3)); \
                if (g == 0) { f32x4 v = xo[q]; v.x += sw * (float)t0; v.y += sw * (float)t1; v.z += sw * (float)t2; v.w += sw * (float)t3; xp[q] = v; ss += (v.x * v.x + v.y * v.y) + (v.z * v.z + v.w * v.w); \
                    if (layer == 0) { u32x2 w; w.x = pk2(v.x * gn[q].x, v.y * gn[q].y); w.y = pk2(v.z * gn[q].z, v.w * gn[q].w); *(u32x2*)(HNo + (size_t)tok * DM + 256 * slice + 16 * i + 4 * q) = w; } } \
            } \
            ss = rowsum16_dpp(ss); \
            if (lane == 15) SSQ[(size_t)slice * NTOK + tok] = ss; \
            if (MORE_) { _Pragma("unroll") for (int q = 0; q < 4; ++q) xo[q] = xp[q + DM / 4]; } \
            sw = swnx; } while (0)
    while (peer_pull(heads, slot, tid, cur, mine, slice, grp)) {
        const unsigned char* VTs = ws + WS_PV + layer * LSTRIDE + (size_t)__builtin_amdgcn_readfirstlane(slice) * N_EXP * 256;
        const int tok0 = grp * PEER_GRP + wave * NT;
        idsb[lane] = EI[(size_t)tok0 * 128 + lane]; idsb[64 + lane] = EI[(size_t)tok0 * 128 + 64 + lane]; if (lane < 32) ((unsigned*)(idsb + 256))[lane] = WQ[(size_t)tok0 * 32 + lane];
        float sw = SW[tok0];
        int e0n = EI[(size_t)(tok0 + 1) * 128 + lane], e1n = EI[(size_t)(tok0 + 1) * 128 + 64 + lane]; unsigned wqn = (lane < 32) ? WQ[(size_t)(tok0 + 1) * 32 + lane] : 0u; float swn = SW[tok0 + 1];
        LDS_FENCE();
        u32x4 vall[32];
        PV_ISSUE(0, idsb); PV_ISSUE(1, idsb); PV_ISSUE(2, idsb); PV_ISSUE(3, idsb);
        f32x4 xo[4];
        f32x4 gn[4];
#pragma unroll
        for (int q = 0; q < 4; ++q) gn[q] = *(const f32x4*)(a->in[I_N1G] + DM + 256 * slice + 16 * i + 4 * q);
        { const f32x4* xp0 = (const f32x4*)(X + (size_t)tok0 * DM + 256 * slice + 16 * i);
#pragma unroll
          for (int q = 0; q < 4; ++q) xo[q] = xp0[q]; }
        int tt = 0;
#pragma unroll 1
        for (; tt < NT - 1; ++tt) PV_TOKEN(1);
        PV_TOKEN(0);
        LDS_FENCE();
    }
#undef PV_ISSUE
#undef PV_Q
#undef PV_COMP
#undef PV_TOKEN
#undef PV_PIN
}
__device__ __forceinline__ void phase_peer_norm(ArgsP a, const int tid, int layer) {
    const int lane = tid & 63, wave = tid >> 6;
    const int gw = blockIdx.x * 8 + wave, NGW = gridDim.x * 8;
    unsigned char* ws = a->ws;
    const float* X = (const float*)(ws + WS_X);
    const float* SSQ = (const float*)(ws + WS_SSQ + layer * LSTRIDE);
    const f32x4* g = (const f32x4*)a->in[I_FING];
    f32x4 gv[8];
#pragma unroll
    for (int j = 0; j < 8; ++j) gv[j] = g[lane + 64 * j];
    for (int t0 = gw; t0 < NTOK; t0 += 4 * NGW) {
        f32x4 v[4][8]; float sq[4];
#pragma unroll
        for (int r = 0; r < 4; ++r) { const int tok = t0 + r * NGW; sq[r] = 0.f; if (tok < NTOK) {
            sq[r] = SSQ[(size_t)(lane & 7) * NTOK + tok];
#pragma unroll
            for (int j = 0; j < 8; ++j) v[r][j] = ((const f32x4*)(X + (size_t)tok * DM))[lane + 64 * j]; } }
#pragma unroll
        for (int r = 0; r < 4; ++r) { const int tok = t0 + r * NGW; if (tok < NTOK) {
            float sqs = sq[r]; sqs += SHX(sqs, 1); sqs += SHX(sqs, 2); sqs += SHX(sqs, 4);
            const float rs = rsqrtf(sqs * (1.f / DM) + 1e-6f);
            { f32x4* o = (f32x4*)(a->out + (size_t)tok * DM);
#pragma unroll
                for (int j = 0; j < 8; ++j) o[lane + 64 * j] = v[r][j] * rs * gv[j]; } } }
    }
}
#ifndef EN_MASK
#define EN_MASK 8191
#endif
#ifndef PROBE7
#define PROBE7 0
#endif
#ifndef REP_MASK
#define REP_MASK 0
#endif
__global__ void __launch_bounds__(512, 2) hybrid_fwd(Args args) {
    extern __shared__ __attribute__((aligned(16))) unsigned char lds[];
    const int G = gridDim.x;
    volatile LAS unsigned* MISC = (volatile LAS unsigned*)((LAS unsigned char*)lds + MISC_OFF);
    const int wave_s = __builtin_amdgcn_readfirstlane((int)threadIdx.x >> 6);
#define CUR_TID() (wave_s * 64 + lane_now())
    for (int u = threadIdx.x; u < (LDS_BYTES - MISC_OFF) / 4; u += 512) MISC[u] = 0u;
    __syncthreads();
    const int ph_lo = args.ph_lo, ph_hi = args.ph_hi;
    const bool multi = (ph_hi - ph_lo) > 1;
    XcdBarrier bar; bar.bar = (unsigned*)(args.ws + WS_CTL); bar.x = 0; bar.st = nullptr;
    if (multi) bar = xcd_barrier_post((unsigned*)(args.ws + WS_CTL), MISC + 8, CUR_TID());
    LAS unsigned char* ldsp = (LAS unsigned char*)lds;
    for (int ph = ph_lo; ph < ph_hi; ++ph) {
        if (ph == NSUB) continue;
        ArgsP a = (ArgsP)__builtin_amdgcn_kernarg_segment_ptr(); asm volatile("" : "+s"(a));
        int tid = CUR_TID(); asm volatile("" : "+v"(tid));
        const int sub_ = (ph == 0) ? 15 : (ph - 1) % NSUB;
        const int nrep = ((REP_MASK >> sub_) & 1) ? 2 : 1;
        for (int rep = 0; rep < nrep; ++rep) {
        if (rep) xcd_barrier(bar, tid);
        if (ph == 0) { if (EN_MASK & 1024) { int tq = tid; asm volatile("" : "+v"(tq)); phase_prologue(a, tq, lds); } }
        else {
            const int layer = (ph - 1) / NSUB, sub = (ph - 1) % NSUB;
            unsigned char* ws = a->ws;
            switch (sub) {
            case 0: if (EN_MASK & 1) { int tq = tid; asm volatile("" : "+v"(tq));
                      pg8::Gemm g{(const bf16_t*)(ws + WS_HN), (const bf16_t*)(ws + WS_WIN) + (size_t)layer * ZLD * DM, NTOK, ZC_CG, DM};
                      RsOrder S; S.S.init(NTOK, ZC_CG, G, (int)blockIdx.x); S.P = (const float*)(ws + WS_SSQ); S.np = layer ? 8 : 0; S.rsb = (LAS float*)(ldsp + RS_OFF); S.wave_s = wave_s; S.k = 0;
                      EpiZ E{(bf16_t*)(ws + WS_Z), (float*)(ws + WS_GATE), 0, ZC_GT / 256, (const LAS float*)(ldsp + RS_OFF), 0}; pg8::gemm_phase<EpiZ, RsOrder, true, true>(tq, ldsp, g, S, E); } break;
            case 1: if (EN_MASK & 2) { int tq = tid; asm volatile("" : "+v"(tq));
                      pg8::Gemm g{(const bf16_t*)(ws + WS_HN), (const bf16_t*)(ws + WS_WIN) + ((size_t)layer * ZLD + ZC_CG) * DM, NTOK, ZLD - ZC_CG, DM};
                      RsOrder S; S.S.init(NTOK, ZLD - ZC_CG, G, (int)blockIdx.x); S.P = (const float*)(ws + WS_SSQ); S.np = layer ? 8 : 0; S.rsb = (LAS float*)(ldsp + RS_OFF); S.wave_s = wave_s; S.k = 0;
                      EpiZ E{(bf16_t*)(ws + WS_Z), (float*)(ws + WS_GATE), ZC_CG, -1, (const LAS float*)(ldsp + RS_OFF), 0}; pg8::gemm_phase<EpiZ, RsOrder, true, true>(tq, ldsp, g, S, E);
                      phase_gates_b1(a, tq, layer, lds, S.S.nwg); } break;
            case 2: if (EN_MASK & 4) { int tq = tid; asm volatile("" : "+v"(tq)); phase_mixers(a, tq, layer, lds, rep); } break;
            case 3: if (EN_MASK & 8) { int tq = tid; asm volatile("" : "+v"(tq));  pg8::Gemm g{(const bf16_t*)(ws + WS_CACT), (const bf16_t*)(ws + WS_WPW) + (size_t)layer * C_W * C_W, NTOK, C_W, C_W}; pg8::StaticOrder S; S.init(NTOK, C_W, G, (int)blockIdx.x);
                      EpiF32 E{(float*)(ws + WS_YCR), C_W, a->in[I_CPWB] + layer * C_W}; pg8::gemm_phase<EpiF32, pg8::StaticOrder, true, true>(tq, ldsp, g, S, E); ycnorm_unit(a, tq, layer, (int)blockIdx.x); phase_mlstm_out(a, tq, layer, lds, rep); } break;
            case 4: if (EN_MASK & 32) { int tq = tid; asm volatile("" : "+v"(tq));  pg8::Gemm g{(const bf16_t*)(ws + WS_Y), (const bf16_t*)(ws + WS_WOUT) + (size_t)layer * DM * DM, NTOK, DM, DM}; pg8::StaticOrder S; S.init(NTOK, DM, G, (int)blockIdx.x);
                      EpiResidN E{layer == 0 ? a->in[I_X] : (const float*)(ws + WS_X), (float*)(ws + WS_X), (bf16_t*)(ws + WS_HN), a->in[I_N2G] + layer * DM, (float*)(ws + WS_P2)};
                      pg8::gemm_phase<EpiResidN, pg8::StaticOrder, true, true>(tq, ldsp, g, S, E); } break;
            case 5: if (EN_MASK & 128) { int tq = tid; asm volatile("" : "+v"(tq));  pg8::Gemm g{(const bf16_t*)(ws + WS_HN), (const bf16_t*)(ws + WS_WQ) + (size_t)layer * DM * DM, NTOK, DM, DM};
                      RsOrder S; S.S.init(NTOK, DM, G, (int)blockIdx.x); S.P = (const float*)(ws + WS_P2); S.np = 32; S.rsb = (LAS float*)(ldsp + RS_OFF); S.wave_s = wave_s; S.k = 0;
                      EpiF32R E{(float*)(ws + WS_Q), DM, (const LAS float*)(ldsp + RS_OFF), 0}; pg8::gemm_phase<EpiF32R, RsOrder, true, true>(tq, ldsp, g, S, E); } break;
            case 6: if (EN_MASK & 256) { int tq = tid; asm volatile("" : "+v"(tq)); phase_peer_route(a, tq, layer, lds, true);
                      if ((tq >> 6) >= 4) { peer_convert_tables(a, layer, tq, 0, CONV_SPLIT); peer_quant_tokens(a, layer, tq); } else peer_convert_tables(a, layer, tq, CONV_SPLIT, 32); } break;
            case 7: if (EN_MASK & 512) { int tq = tid; asm volatile("" : "+v"(tq)); phase_peer_u(a, tq, layer, lds, rep); } break;
            case 8: if (EN_MASK & 512) { int tq = tid; asm volatile("" : "+v"(tq)); phase_peer_a(a, tq, layer, lds); } break;
            case 9: if (EN_MASK & 2048) { int tq = tid; asm volatile("" : "+v"(tq)); phase_peer_v(a, tq, layer, lds); } break;
            default: if (EN_MASK & 4096) { int tq = tid; asm volatile("" : "+v"(tq)); phase_peer_norm(a, tq, layer); } break;
            }
        }
        }
        if (ph + 1 < ph_hi) xcd_barrier(bar, CUR_TID());
    }
}

extern "C" void kernel_launch(void* const* d_in, const int* in_sizes, int n_in, void* d_out, int out_size, void* d_ws, size_t ws_size, hipStream_t stream) {
    static int grid = 0;
    if (grid == 0) {
        if (n_in != 21 || in_sizes[0] != NTOK * DM || out_size != NTOK * DM || ws_size < WS_END) { fprintf(stderr, "kernel_launch: unexpected shapes (n_in %d, in0 %d, out %d, ws %zu)\n", n_in, n_in > 0 ? in_sizes[0] : -1, out_size, ws_size); grid = -1; return; }
        int dev = 0, cus = 0;
        if (hipGetDevice(&dev) != hipSuccess || hipDeviceGetAttribute(&cus, hipDeviceAttributeMultiprocessorCount, dev) != hipSuccess) { grid = -1; return; }
        if (hipFuncSetAttribute((const void*)hybrid_fwd, hipFuncAttributeMaxDynamicSharedMemorySize, LDS_BYTES) != hipSuccess) { fprintf(stderr, "kernel_launch: hipFuncSetAttribute failed\n"); grid = -1; return; }
        (void)hipGetLastError();
        if (cus < 192) { fprintf(stderr, "kernel_launch: needs at least 192 CUs (row-scale slots), got %d\n", cus); grid = -1; return; }
        grid = cus;
    }
    if (grid < 0) return;
    (void)hipMemsetAsync((char*)d_ws + WS_CTL, 0, CTL_ZERO_BYTES, stream);
    Args a{};
    for (int i = 0; i < 21; ++i) a.in[i] = (const float*)d_in[i];
    a.out = (float*)d_out; a.ws = (unsigned char*)d_ws;
#if MK_ONE_LAUNCH
    a.ph_lo = 0; a.ph_hi = NPHASE;
    hipLaunchKernelGGL(hybrid_fwd, dim3(grid), dim3(512), LDS_BYTES, stream, a);
#else
    for (int ph = 0; ph < NPHASE; ++ph) { a.ph_lo = ph; a.ph_hi = ph + 1; hipLaunchKernelGGL(hybrid_fwd, dim3(grid), dim3(512), LDS_BYTES, stream, a); }
#endif
}
```

```cpp
#include <hip/hip_runtime.h>
#include <cstdio>
#include <cstdint>
namespace pg8 {
#define PG8_LAS __attribute__((address_space(3)))
typedef unsigned short bf16_t;
typedef short bf16x8 __attribute__((ext_vector_type(8)));
typedef float f32x4 __attribute__((ext_vector_type(4)));
typedef unsigned u32x4 __attribute__((ext_vector_type(4)));
constexpr int BM = 256, BK = 64, HALF = 128, HTB = HALF * BK * 2  , STAGE_BYTES = 8 * HTB, NXCD = 8, WGM = 8;

__host__ __device__ __forceinline__ int lds_byte(int r, int c) { const int st = (r >> 4) * 2 + (c >> 5), rr = r & 15, cc = c & 31, ob = rr * 64 + cc * 2; return st * 1024 + (ob ^ (((ob >> 9) & 1) << 5)); }
__host__ __device__ __forceinline__ void stage_rc(int b, int& R, int& C) { const int st = b / 1024, sb = b % 1024, swz = sb ^ (((sb >> 9) & 1) << 5); R = (st >> 1) * 16 + swz / 64; C = (st & 1) * 32 + (swz % 64) / 2; }
__host__ __device__ __forceinline__ int perm32(int rho) { const int n = rho >> 4, i = rho & 15; return 8 * (i >> 2) + 4 * n + (i & 3); }

struct Unit { int pm, pn; };
struct Gemm { const bf16_t* A; const bf16_t* Bt; int M, N, K; };

struct StaticOrder {
    int nM, nN, nwg, G, c;
    __host__ __device__ void init(int M, int N, int G_, int c_) { nM = M / BM; nN = N / BM; nwg = nM * nN; G = G_; c = c_; }
    __host__ __device__ bool next(int i, Unit& u) const {
        const long L = (long)i * G + c; if (L >= nwg) return false;
        int wgid = (int)L; { const int q = nwg / NXCD, r = nwg % NXCD, xcd = wgid % NXCD, off = wgid / NXCD; wgid = (xcd < r ? xcd * (q + 1) : r * (q + 1) + (xcd - r) * q) + off; }
        const int nig = WGM * nN, gid = wgid / nig, fm = gid * WGM, gsz = (nM - fm) < WGM ? (nM - fm) : WGM;
        u.pm = fm + ((wgid % nig) % gsz); u.pn = (wgid % nig) / gsz; return true;
    }
    __device__ __forceinline__ void a_ready(const Unit&) const {}
    __device__ __forceinline__ void done(const Unit&) const {}
};

__device__ __forceinline__ unsigned cvt_pk_bf16(float lo, float hi) { unsigned r; asm volatile("v_cvt_pk_bf16_f32 %0, %1, %2" : "=v"(r) : "v"(lo), "v"(hi)); return r; }
template <class Epi, class Sched, bool ALIGN_EPI = false, bool SP2 = false>
__device__ __forceinline__ void gemm_phase(const int tid, PG8_LAS unsigned char* lds, const Gemm g, const Sched& S, const Epi& E) {
    const int wid = __builtin_amdgcn_readfirstlane(tid >> 6), lane = tid & 63, wr = wid >> 2, wc = wid & 3, fr = lane & 15, fq = lane >> 4;
    const int K = g.K, nt = K / BK;
    unsigned voffA[2], voffB[2];
#pragma unroll
    for (int i = 0; i < 2; ++i) { int R, C; stage_rc(tid * 16 + i * 8192, R, C); const int Rb = Epi::PERM ? ((R & ~31) + perm32(R & 31)) : R;
        voffA[i] = (unsigned)(R * K + C) * 2u; voffB[i] = (unsigned)(Rb * K + C) * 2u; }
    const size_t kstep = (size_t)(BK * 2);
    const size_t hstep = (size_t)HALF * K * 2;
    const size_t tstep = 2 * hstep;
    const unsigned ldsw = (unsigned)wid * 1024u;
    const int aoff = lds_byte(wr * 64 + fr, fq * 8), boff = lds_byte(wc * 32 + fr, fq * 8);
#define PG8_SA(b, h) (((b) * 2 + (h)) * HTB)
#define PG8_SB(b, h) ((4 + (b) * 2 + (h)) * HTB)
#define PG8_STAGE(bufoff, gbase, voff) do { _Pragma("unroll") for (int _i = 0; _i < 2; ++_i) \
        __builtin_amdgcn_global_load_lds((const unsigned*)((const char*)(gbase) + (voff)[_i]), (PG8_LAS unsigned*)(lds + (bufoff) + ldsw + _i * 8192), 16, 0, 0); } while (0)
#define PG8_LDA(dst, b, h) do { _Pragma("unroll") for (int m = 0; m < 4; ++m) _Pragma("unroll") for (int k = 0; k < 2; ++k) dst[m][k] = *(const PG8_LAS bf16x8*)(lds + PG8_SA(b, h) + aoff + m * 2048 + k * 1024); } while (0)
#define PG8_LDB(dst, b, h) do { _Pragma("unroll") for (int n = 0; n < 2; ++n) _Pragma("unroll") for (int k = 0; k < 2; ++k) dst[n][k] = *(const PG8_LAS bf16x8*)(lds + PG8_SB(b, h) + boff + n * 2048 + k * 1024); } while (0)
#define PG8_MMA(ai, bj, At, Bt) do { __builtin_amdgcn_s_setprio(1); _Pragma("unroll") for (int m = 0; m < 4; ++m) _Pragma("unroll") for (int n = 0; n < 2; ++n) _Pragma("unroll") for (int k = 0; k < 2; ++k) \
        acc[ai][bj][m][n] = __builtin_amdgcn_mfma_f32_16x16x32_bf16(Bt[n][k], At[m][k], acc[ai][bj][m][n], 0, 0, 0); __builtin_amdgcn_s_setprio(0); } while (0)
#define PG8_WAIT_V(n) asm volatile("s_waitcnt vmcnt(" #n ")" ::: "memory")
#define PG8_WAIT_L(n) asm volatile("s_waitcnt lgkmcnt(" #n ")" ::: "memory")
#define PG8_BAR __builtin_amdgcn_s_barrier()
#define PG8_SCHED __builtin_amdgcn_sched_barrier(0)
    Unit cur, nxt; int ui = 0;
    if (!S.next(0, cur)) return;
    f32x4 acc[2][2][4][2];
#pragma unroll
    for (int a = 0; a < 2; ++a)
#pragma unroll
        for (int b = 0; b < 2; ++b)
#pragma unroll
            for (int m = 0; m < 4; ++m)
#pragma unroll
                for (int n = 0; n < 2; ++n) acc[a][b][m][n] = (f32x4){0.f, 0.f, 0.f, 0.f};
    bf16x8 At[4][2], B0[2][2], B1[2][2];
    const char* cA = (const char*)g.A + (size_t)cur.pm * tstep; const char* cB = (const char*)g.Bt + (size_t)cur.pn * tstep;
    if constexpr (SP2) {
        PG8_STAGE(PG8_SB(0, 0), cB, voffB); PG8_STAGE(PG8_SB(0, 1), cB + hstep, voffB); PG8_STAGE(PG8_SA(0, 0), cA, voffA); PG8_STAGE(PG8_SA(0, 1), cA + hstep, voffA);
        S.a_ready(cur);
        if (wr == 1) PG8_BAR;
        PG8_WAIT_V(2); PG8_BAR;
        PG8_STAGE(PG8_SB(1, 0), cB + kstep, voffB); PG8_STAGE(PG8_SA(1, 0), cA + kstep, voffA); PG8_STAGE(PG8_SB(1, 1), cB + hstep + kstep, voffB);
        PG8_WAIT_V(6); PG8_BAR;
    } else {
        PG8_STAGE(PG8_SB(0, 0), cB, voffB); PG8_STAGE(PG8_SA(0, 0), cA, voffA); PG8_STAGE(PG8_SB(0, 1), cB + hstep, voffB); PG8_STAGE(PG8_SA(0, 1), cA + hstep, voffA);
        S.a_ready(cur);
        if (wr == 1) PG8_BAR;
        PG8_WAIT_V(4); PG8_BAR;
        PG8_STAGE(PG8_SB(1, 0), cB + kstep, voffB); PG8_STAGE(PG8_SA(1, 0), cA + kstep, voffA); PG8_STAGE(PG8_SB(1, 1), cB + hstep + kstep, voffB);
        PG8_WAIT_V(6); PG8_BAR;
    }
    for (;;) {
        const bool has_next = S.next(ui + 1, nxt);
        const char* nA = has_next ? (const char*)g.A + (size_t)nxt.pm * tstep : cA; const char* nB = has_next ? (const char*)g.Bt + (size_t)nxt.pn * tstep : cB;
        for (int t = 0; t < nt; t += 2) {
            const bool last = (t == nt - 2);
            const char* a1 = cA + (size_t)(t + 1) * kstep;
            const char* a2 = last ? nA : cA + (size_t)(t + 2) * kstep; const char* b2 = last ? nB : cB + (size_t)(t + 2) * kstep;
            const char* a3 = a2 + kstep; const char* b3 = b2 + kstep;
            if (last && has_next) S.a_ready(nxt);
            if constexpr (SP2) {
            PG8_LDB(B0, 0, 0); PG8_LDB(B1, 0, 1); PG8_SCHED; PG8_LDA(At, 0, 0); PG8_STAGE(PG8_SA(1, 1), a1 + hstep, voffA);
            PG8_WAIT_V(8); PG8_WAIT_L(0); PG8_BAR; PG8_MMA(0, 0, At, B0); PG8_MMA(0, 1, At, B1); PG8_BAR; PG8_SCHED;
            PG8_LDA(At, 0, 1); PG8_STAGE(PG8_SB(0, 0), b2, voffB); PG8_STAGE(PG8_SB(0, 1), b2 + hstep, voffB); PG8_STAGE(PG8_SA(0, 0), a2, voffA);
            PG8_WAIT_V(8); PG8_WAIT_L(0); PG8_BAR; PG8_MMA(1, 0, At, B0); PG8_MMA(1, 1, At, B1); PG8_BAR; PG8_SCHED;
            PG8_LDB(B0, 1, 0); PG8_LDB(B1, 1, 1); PG8_SCHED; PG8_LDA(At, 1, 0); PG8_STAGE(PG8_SA(0, 1), a2 + hstep, voffA);
            PG8_WAIT_V(8); PG8_WAIT_L(0); PG8_BAR; PG8_MMA(0, 0, At, B0); PG8_MMA(0, 1, At, B1); PG8_BAR; PG8_SCHED;
            PG8_LDA(At, 1, 1); PG8_STAGE(PG8_SB(1, 0), b3, voffB); PG8_STAGE(PG8_SB(1, 1), b3 + hstep, voffB); PG8_STAGE(PG8_SA(1, 0), a3, voffA);
            PG8_WAIT_V(8); PG8_WAIT_L(0); PG8_BAR; PG8_MMA(1, 0, At, B0); PG8_MMA(1, 1, At, B1); PG8_BAR; PG8_SCHED;
            } else {
            PG8_LDB(B0, 0, 0); PG8_SCHED; PG8_LDA(At, 0, 0); PG8_STAGE(PG8_SA(1, 1), a1 + hstep, voffA);
            PG8_WAIT_L(8); PG8_BAR; PG8_WAIT_L(0); PG8_MMA(0, 0, At, B0); PG8_BAR; PG8_SCHED;
            PG8_LDB(B1, 0, 1); PG8_STAGE(PG8_SB(0, 0), b2, voffB);
            PG8_BAR; PG8_WAIT_L(0); PG8_MMA(0, 1, At, B1); PG8_BAR;
            PG8_LDA(At, 0, 1); PG8_STAGE(PG8_SA(0, 0), a2, voffA);
            PG8_BAR; PG8_WAIT_L(0); PG8_MMA(1, 0, At, B0); PG8_BAR; PG8_SCHED;
            PG8_STAGE(PG8_SB(0, 1), b2 + hstep, voffB);
            PG8_WAIT_V(6); PG8_BAR; PG8_MMA(1, 1, At, B1); PG8_BAR;
            PG8_LDB(B0, 1, 0); PG8_SCHED; PG8_LDA(At, 1, 0); PG8_STAGE(PG8_SA(0, 1), a2 + hstep, voffA);
            PG8_WAIT_L(8); PG8_BAR; PG8_WAIT_L(0); PG8_MMA(0, 0, At, B0); PG8_BAR; PG8_SCHED;
            PG8_LDB(B1, 1, 1); PG8_STAGE(PG8_SB(1, 0), b3, voffB);
            PG8_BAR; PG8_WAIT_L(0); PG8_MMA(0, 1, At, B1); PG8_BAR;
            PG8_LDA(At, 1, 1); PG8_STAGE(PG8_SA(1, 0), a3, voffA);
            PG8_BAR; PG8_WAIT_L(0); PG8_MMA(1, 0, At, B0); PG8_BAR; PG8_SCHED;
            PG8_STAGE(PG8_SB(1, 1), b3 + hstep, voffB);
            PG8_WAIT_V(6); PG8_BAR; PG8_MMA(1, 1, At, B1); PG8_BAR;
            }
        }
        if constexpr (ALIGN_EPI) { if (wr == 0) PG8_BAR; }
        if constexpr (!Epi::AFTER_DRAIN) { E(acc, cur, wr, wc, fr, fq); S.done(cur); }
        if (!has_next) break;
#pragma unroll
        for (int a = 0; a < 2; ++a)
#pragma unroll
            for (int b = 0; b < 2; ++b)
#pragma unroll
                for (int m = 0; m < 4; ++m)
#pragma unroll
                    for (int n = 0; n < 2; ++n) acc[a][b][m][n] = (f32x4){0.f, 0.f, 0.f, 0.f};
        cur = nxt; cA = nA; cB = nB; ++ui;
        if constexpr (ALIGN_EPI) { if (wr == 1) PG8_BAR; }
    }
    PG8_WAIT_V(0);
    if constexpr (!ALIGN_EPI) { if (wr == 0) PG8_BAR; }
    PG8_BAR;
    if constexpr (Epi::AFTER_DRAIN) { E.fused(acc, cur, wr, wc, fr, fq, lds, wid, lane); S.done(cur); }
#undef PG8_SA
#undef PG8_SB
#undef PG8_STAGE
#undef PG8_LDA
#undef PG8_LDB
#undef PG8_MMA
#undef PG8_WAIT_V
#undef PG8_WAIT_L
#undef PG8_BAR
#undef PG8_SCHED
}
}

#ifndef MK_ONE_LAUNCH
#define MK_ONE_LAUNCH 1
#endif
constexpr int NTOK = 8192, SEQ = 4096, DM = 2048, ZLD = 6656;
constexpr int A_H = 6, A_D = 128, B_H = 4, B_D = 192, C_W = 512, C_K = 31;
constexpr int P_H = 8, N_KEYS = 128, P_TOPK = 16, N_EXP = 16384;
constexpr int ZC_AQ = 0, ZC_AK = 768, ZC_AV = 1536, ZC_BQK = 2304, ZC_BV = 3840, ZC_BO = 4608, ZC_CA = 5376, ZC_GT = 5888, ZC_CG = 6144;
constexpr int NSUB = 11, NPHASE = 1 + 2 * NSUB;

constexpr size_t MiB = 1u << 20;
constexpr size_t WS_CTL = 0, CTL_ZERO_BYTES = 64 * 1024;
constexpr size_t WS_WIN = 2 * MiB;
constexpr size_t WS_WOUT = 56 * MiB;
constexpr size_t WS_WQ = 72 * MiB;
constexpr size_t WS_WPW = 88 * MiB;
constexpr size_t WS_EGU_ = 434 * MiB, WS_PS_ = 640 * MiB, LSTRIDE_ = 116 * MiB;
constexpr size_t WS_KH = 90 * MiB, WS_KL = 91 * MiB;
constexpr size_t WS_X = 96 * MiB;
constexpr size_t WS_HN = 160 * MiB;
constexpr size_t WS_Z = 192 * MiB;
constexpr size_t WS_GATE = 296 * MiB;
constexpr size_t WS_CFOX = 297 * MiB;
constexpr size_t WS_Y = 298 * MiB;
constexpr size_t WS_CACT = 330 * MiB;
constexpr size_t WS_YCR = 338 * MiB;
constexpr size_t WS_Q = 354 * MiB;
constexpr size_t WS_EIDX = 418 * MiB;
constexpr size_t WS_EGATE = 422 * MiB;
constexpr size_t WS_P2 = 808 * MiB;
constexpr size_t WS_END = 810 * MiB;

constexpr int RING_BYTES = 131072;
constexpr int MISC_OFF = RING_BYTES;
constexpr int RS_OFF = RING_BYTES + 1024;
constexpr int RT_TAB_OFF = RS_OFF + 4096;
constexpr int LDS_BYTES = RING_BYTES + 1024 + 4096 + 8448;

typedef unsigned short bf16_t;
typedef float f32x4 __attribute__((ext_vector_type(4)));
typedef unsigned u32x4 __attribute__((ext_vector_type(4)));
typedef unsigned u32x2 __attribute__((ext_vector_type(2)));
#define LAS __attribute__((address_space(3)))

__device__ __forceinline__ unsigned f2bf(float f) { const __bf16 h = (__bf16)f; return (unsigned)__builtin_bit_cast(unsigned short, h); }
typedef float f32x2_ __attribute__((ext_vector_type(2)));
typedef __bf16 bf16x2_ __attribute__((ext_vector_type(2)));
__device__ __forceinline__ unsigned pk2(float lo, float hi) { const f32x2_ v = {lo, hi}; const bf16x2_ r = __builtin_convertvector(v, bf16x2_); return __builtin_bit_cast(unsigned, r); }
__device__ __forceinline__ float bf_lo(unsigned w) { return __builtin_bit_cast(float, w << 16); }
__device__ __forceinline__ float bf_hi(unsigned w) { return __builtin_bit_cast(float, w & 0xffff0000u); }
__device__ __forceinline__ float bf2f(bf16_t b) { return __builtin_bit_cast(float, ((unsigned)b) << 16); }
#define SHX(v, m) __builtin_bit_cast(float, __builtin_amdgcn_ds_bpermute(((lane) ^ (m)) << 2, __builtin_bit_cast(int, (float)(v))))
#define SHXI(v, m) __builtin_amdgcn_ds_bpermute(((lane) ^ (m)) << 2, (int)(v))
#define SHUP(v, d) __builtin_bit_cast(float, __builtin_amdgcn_ds_bpermute((((lane) >= (d)) ? (lane) - (d) : (lane)) << 2, __builtin_bit_cast(int, (float)(v))))
#define SHIDX(v, s) __builtin_bit_cast(float, __builtin_amdgcn_ds_bpermute((s) << 2, __builtin_bit_cast(int, (float)(v))))
#define SHIDXI(v, s) __builtin_amdgcn_ds_bpermute((s) << 2, (int)(v))
#define RDLANE(v, k) __builtin_bit_cast(float, __builtin_amdgcn_readlane(__builtin_bit_cast(int, (float)(v)), (k)))
__device__ __forceinline__ float wave_sum(float v, const int lane) {
#pragma unroll
    for (int o = 32; o > 0; o >>= 1) v += SHX(v, o);
    return v;
}
__device__ __forceinline__ float wave_max(float v, const int lane) {
#pragma unroll
    for (int o = 32; o > 0; o >>= 1) v = fmaxf(v, SHX(v, o));
    return v;
}
__device__ __forceinline__ float sigmoidf_(float x) { return __builtin_amdgcn_rcpf(1.f + __expf(-x)); }
__device__ __forceinline__ float log_sigmoidf_(float x) { return fminf(x, 0.f) - log1pf(__expf(-fabsf(x))); }
#define LDS_FENCE() asm volatile("s_waitcnt lgkmcnt(0)" ::: "memory")
__device__ __forceinline__ float rowsum16_dpp(float v) {
#define RS_STEP(c_) v += __builtin_bit_cast(float, __builtin_amdgcn_update_dpp(0, __builtin_bit_cast(int, v), c_, 0xf, 0xf, true));
    RS_STEP(0x111) RS_STEP(0x112) RS_STEP(0x114) RS_STEP(0x118)
#undef RS_STEP
    return v;
}

#define XB_TMO      128
#define XB_XCNT(j)  (256  + 64 * (j))
#define XB_XSUB(j)  (1280 + 64 * (j))
#define XB_XGEN(j)  (2304 + 64 * (j))
#define XB_TOP      3328
#define XB_TOPGEN   3392
#define XCD_BAR_WORDS 3456
#define XB_SPIN_CAP (1u << 22)
__device__ __forceinline__ unsigned xb_ld(unsigned* p)              { return __hip_atomic_load(p, __ATOMIC_RELAXED, __HIP_MEMORY_SCOPE_AGENT); }
__device__ __forceinline__ unsigned xb_add(unsigned* p, unsigned v) { return __hip_atomic_fetch_add(p, v, __ATOMIC_RELAXED, __HIP_MEMORY_SCOPE_AGENT); }
__device__ __forceinline__ unsigned xb_xcc_id() { return (unsigned)__builtin_amdgcn_s_getreg((3 << 11) | 20) & 0xFu; }
#define XB_SPIN(cond, bar) do { unsigned _sp = 0; while (cond) { __builtin_amdgcn_s_sleep(1); \
    if ((++_sp & 255u) == 0u) { if (xb_ld(&(bar)[XB_TMO])) break; if (_sp > XB_SPIN_CAP) { atomicAdd(&(bar)[XB_TMO], 1u); break; } } } } while (0)
struct XcdBarrier { unsigned* bar; unsigned x; volatile LAS unsigned* st; };
__device__ __forceinline__ XcdBarrier xcd_barrier_post(unsigned* bar, volatile LAS unsigned* st, const int tid) {
    XcdBarrier b; b.bar = bar; b.x = xb_xcc_id(); b.st = st;
    if (tid == 0) (void)xb_add(&bar[XB_XCNT(b.x)], 1u);
    return b;
}
__device__ __forceinline__ void xcd_barrier_complete(unsigned* bar, unsigned x, unsigned& nloc, unsigned& nx) {
    const unsigned G = gridDim.x * gridDim.y * gridDim.z;
    unsigned sum, cnt, mine, sp = 0u;
    for (;;) {
        sum = 0u; cnt = 0u; mine = 0u;
#pragma unroll
        for (unsigned j = 0; j < 16; ++j) { const unsigned c = xb_ld(&bar[XB_XCNT(j)]); sum += c; cnt += (c > 0u) ? 1u : 0u; mine = (j == x) ? c : mine; }
        if (sum == G) break;
        __builtin_amdgcn_s_sleep(1);
        if ((++sp & 255u) == 0u) { if (xb_ld(&bar[XB_TMO])) break; if (sp > XB_SPIN_CAP) { atomicAdd(&bar[XB_TMO], 1u); break; } }
    }
    nloc = mine > 0u ? mine : 1u; nx = cnt > 0u ? cnt : 1u;
}
__device__ __forceinline__ void xcd_barrier(const XcdBarrier& b, const int tid) {
    asm volatile("s_waitcnt vmcnt(0)" ::: "memory");
    __syncthreads();
    if (tid == 0) {
        unsigned* bar = b.bar;
        __builtin_amdgcn_s_waitcnt(0);
        unsigned nloc = b.st[0], nx = b.st[1];
        if (nloc == 0u) { xcd_barrier_complete(bar, b.x, nloc, nx); b.st[0] = nloc; b.st[1] = nx; }
        const unsigned old = xb_add(&bar[XB_XSUB(b.x)], 1u);
        const unsigned gen = old / nloc;
        if (old + 1u == (gen + 1u) * nloc) {
            __builtin_amdgcn_fence(__ATOMIC_RELEASE, "agent");
            asm volatile("s_waitcnt vmcnt(0)" ::: "memory");
            const unsigned og = xb_add(&bar[XB_TOP], 1u);
            const unsigned tg = og / nx;
            if (og + 1u == (tg + 1u) * nx) xb_add(&bar[XB_TOPGEN], 1u);
            else XB_SPIN(xb_ld(&bar[XB_TOPGEN]) == tg, bar);
            __builtin_amdgcn_fence(__ATOMIC_ACQUIRE, "agent");
            xb_add(&bar[XB_XGEN(b.x)], 1u);
            asm volatile("s_waitcnt vmcnt(0)" ::: "memory");
        } else {
            __builtin_amdgcn_fence(__ATOMIC_ACQUIRE, "agent");
            XB_SPIN(xb_ld(&bar[XB_XGEN(b.x)]) == gen, bar);
            asm volatile("s_waitcnt vmcnt(0)" ::: "memory");
        }
    }
    __syncthreads();
}

struct Args { const float* in[21]; float* out; unsigned char* ws; int ph_lo, ph_hi; };
typedef const __attribute__((address_space(4))) Args* ArgsP;
enum { I_X = 0, I_WIN, I_FOXB, I_MCONVW, I_MIB, I_MFB, I_CDWW, I_CDWB, I_CLNG, I_CLNB, I_CPWW, I_CPWB, I_ONG, I_WOUT, I_N1G, I_N2G, I_PWQ, I_PKEYS, I_PU, I_PV, I_FING };

__device__ __forceinline__ int lane_now() { int l; asm volatile("v_mbcnt_lo_u32_b32 %0, -1, 0\n\tv_mbcnt_hi_u32_b32 %0, -1, %0" : "=v"(l)); return l; }
struct EpiZ {
    static constexpr bool PERM = true, AFTER_DRAIN = false;
    bf16_t* Z; float* G; int col_off, gate_tile; const LAS float* rsb; mutable int k;
    __device__ __forceinline__ void operator()(const pg8::f32x4 (&acc)[2][2][4][2], const pg8::Unit& u, int wr, int wc, int fr, int fq) const {
        const int row0 = u.pm * 256 + wr * 64 + fr;
        const LAS float* rr = rsb + (k & 3) * 256 + wr * 64 + fr; ++k;
        if (u.pn != gate_tile) {
            const int col0 = col_off + u.pn * 256 + wc * 32 + 8 * fq;
#pragma unroll
            for (int ai = 0; ai < 2; ++ai)
#pragma unroll
                for (int m = 0; m < 4; ++m) { bf16_t* rowp = Z + (size_t)(row0 + ai * 128 + m * 16) * ZLD + col0; const float rs = rr[ai * 128 + m * 16];
#pragma unroll
                    for (int bj = 0; bj < 2; ++bj) { const pg8::f32x4 v0 = acc[ai][bj][m][0] * rs, v1 = acc[ai][bj][m][1] * rs; u32x4 w;
                        w.x = pg8::cvt_pk_bf16(v0[0], v0[1]); w.y = pg8::cvt_pk_bf16(v0[2], v0[3]); w.z = pg8::cvt_pk_bf16(v1[0], v1[1]); w.w = pg8::cvt_pk_bf16(v1[2], v1[3]);
                        *(u32x4*)(rowp + bj * 128) = w; } }
        } else if (wc == 0 && fq < 2) {
#pragma unroll
            for (int ai = 0; ai < 2; ++ai)
#pragma unroll
                for (int m = 0; m < 4; ++m) { float* gp = G + (size_t)(row0 + ai * 128 + m * 16) * 16 + 8 * fq; const float rs = rr[ai * 128 + m * 16];
                    *(pg8::f32x4*)gp = acc[ai][0][m][0] * rs; *(pg8::f32x4*)(gp + 4) = acc[ai][0][m][1] * rs; }
        }
    }
};
struct EpiResidN {
    static constexpr bool PERM = true, AFTER_DRAIN = false;
    const float* Xin; float* Xout; bf16_t* HN; const float* gain; float* P;
    __device__ __forceinline__ void operator()(const pg8::f32x4 (&acc)[2][2][4][2], const pg8::Unit& u, int wr, int wc, int fr, int fq) const {
        const int lane = fr + 16 * fq;
        const int row0 = u.pm * 256 + wr * 64 + fr, col0 = u.pn * 256 + wc * 32 + 8 * fq;
        pg8::f32x4 gv[2][2];
#pragma unroll
        for (int bj = 0; bj < 2; ++bj) { gv[bj][0] = *(const pg8::f32x4*)(gain + col0 + bj * 128); gv[bj][1] = *(const pg8::f32x4*)(gain + col0 + bj * 128 + 4); }
#pragma unroll
        for (int ai = 0; ai < 2; ++ai)
#pragma unroll
          for (int mp = 0; mp < 2; ++mp) {
            pg8::f32x4 xin[2][2][2];
#pragma unroll
            for (int mm = 0; mm < 2; ++mm)
#pragma unroll
                for (int bj = 0; bj < 2; ++bj) { const size_t off = (size_t)(row0 + ai * 128 + (2 * mp + mm) * 16) * DM + col0 + bj * 128;
                    xin[mm][bj][0] = *(const pg8::f32x4*)(Xin + off); xin[mm][bj][1] = *(const pg8::f32x4*)(Xin + off + 4); }
#pragma unroll
            for (int mm = 0; mm < 2; ++mm) { const int m = 2 * mp + mm; const int row = row0 + ai * 128 + m * 16; const size_t off = (size_t)row * DM + col0;
                float ss = 0.f;
#pragma unroll
                for (int bj = 0; bj < 2; ++bj) {
                    const pg8::f32x4 x0 = xin[mm][bj][0] + acc[ai][bj][m][0], x1 = xin[mm][bj][1] + acc[ai][bj][m][1];
                    *(pg8::f32x4*)(Xout + off + bj * 128) = x0; *(pg8::f32x4*)(Xout + off + bj * 128 + 4) = x1;
                    ss += ((x0[0] * x0[0] + x0[1] * x0[1]) + (x0[2] * x0[2] + x0[3] * x0[3])) + ((x1[0] * x1[0] + x1[1] * x1[1]) + (x1[2] * x1[2] + x1[3] * x1[3]));
                    const pg8::f32x4 h0 = x0 * gv[bj][0], h1 = x1 * gv[bj][1]; u32x4 w;
                    w.x = pg8::cvt_pk_bf16(h0[0], h0[1]); w.y = pg8::cvt_pk_bf16(h0[2], h0[3]); w.z = pg8::cvt_pk_bf16(h1[0], h1[1]); w.w = pg8::cvt_pk_bf16(h1[2], h1[3]);
                    *(u32x4*)(HN + off + bj * 128) = w; }
                ss += SHX(ss, 16); ss += SHX(ss, 32);
                if (fq == 0) P[(size_t)(u.pn * 4 + wc) * NTOK + row] = ss; }
          }
    }
};
struct EpiF32 {
    static constexpr bool PERM = false, AFTER_DRAIN = false;
    float* C; int ldc; const float* bias;
    __device__ __forceinline__ void operator()(const pg8::f32x4 (&acc)[2][2][4][2], const pg8::Unit& u, int wr, int wc, int fr, int fq) const {
        const int row0 = u.pm * 256 + wr * 64 + fr, col0 = u.pn * 256 + wc * 32 + 4 * fq;
        pg8::f32x4 bv[2][2];
#pragma unroll
        for (int bj = 0; bj < 2; ++bj)
#pragma unroll
            for (int n = 0; n < 2; ++n) bv[bj][n] = bias ? *(const pg8::f32x4*)(bias + col0 + bj * 128 + n * 16) : (pg8::f32x4){0.f, 0.f, 0.f, 0.f};
#pragma unroll
        for (int ai = 0; ai < 2; ++ai)
#pragma unroll
            for (int m = 0; m < 4; ++m) { float* rowp = C + (size_t)(row0 + ai * 128 + m * 16) * ldc + col0;
#pragma unroll
                for (int bj = 0; bj < 2; ++bj)
#pragma unroll
                    for (int n = 0; n < 2; ++n) *(pg8::f32x4*)(rowp + bj * 128 + n * 16) = acc[ai][bj][m][n] + bv[bj][n]; }
    }
};

struct EpiF32R {
    static constexpr bool PERM = false, AFTER_DRAIN = false;
    float* C; int ldc; const LAS float* rsb; mutable int k;
    __device__ __forceinline__ void operator()(const pg8::f32x4 (&acc)[2][2][4][2], const pg8::Unit& u, int wr, int wc, int fr, int fq) const {
        const int row0 = u.pm * 256 + wr * 64 + fr, col0 = u.pn * 256 + wc * 32 + 4 * fq;
        const LAS float* rr = rsb + (k & 3) * 256 + wr * 64 + fr; ++k;
#pragma unroll
        for (int ai = 0; ai < 2; ++ai)
#pragma unroll
            for (int m = 0; m < 4; ++m) { float* rowp = C + (size_t)(row0 + ai * 128 + m * 16) * ldc + col0; const float rs = rr[ai * 128 + m * 16];
#pragma unroll
                for (int bj = 0; bj < 2; ++bj)
#pragma unroll
                    for (int n = 0; n < 2; ++n) *(pg8::f32x4*)(rowp + bj * 128 + n * 16) = acc[ai][bj][m][n] * rs; }
    }
};
struct RsOrder {
    pg8::StaticOrder S; const float* P; int np; LAS float* rsb; int wave_s; mutable int k;
    __device__ __forceinline__ bool next(int i, pg8::Unit& u) const { return S.next(i, u); }
    __device__ __forceinline__ void a_ready(const pg8::Unit& u) const {
        if (k == 0) { const int t = wave_s * 64 + lane_now();
            if (t < 256) {
#pragma unroll 1
                for (int i = 0; i < 4; ++i) { pg8::Unit v; if (!S.next(i, v)) break;
                    float s = 0.f; const float* p = P + v.pm * 256 + t;
                    if (np == 32) { float x[32];
#pragma unroll
                        for (int q = 0; q < 32; ++q) x[q] = p[(size_t)q * NTOK];
#pragma unroll
                        for (int q = 0; q < 32; q += 8) s += ((x[q] + x[q + 1]) + (x[q + 2] + x[q + 3])) + ((x[q + 4] + x[q + 5]) + (x[q + 6] + x[q + 7])); }
                    else
#pragma unroll 1
                    for (int j = 0; j < np; j += 8) { float x[8];
#pragma unroll
                        for (int q = 0; q < 8; ++q) x[q] = p[(size_t)(j + q) * NTOK];
                        s += ((x[0] + x[1]) + (x[2] + x[3])) + ((x[4] + x[5]) + (x[6] + x[7])); }
                    rsb[i * 256 + t] = np ? rsqrtf(s * (1.f / DM) + 1e-6f) : 1.f; } } }
        ++k; }
    __device__ __forceinline__ void done(const pg8::Unit&) const {}
};
__device__ __forceinline__ int win_src(int n) {
    if (n < 2304) return n;
    if (n < 5376) return n + 6;
    if (n < 5888) return n + 14;
    if (n < 6144) { const int g = n - 5888;
        if (g < 6) return 2304 + g;
        if (g < 14) return 5382 + (g - 6);
        return -1; }
    return 5902 + (n - 6144);
}
typedef float f32x2 __attribute__((ext_vector_type(2)));
__device__ __forceinline__ void transpose_item(const float* W, int K, int N, bf16_t* WT, int NB, float* scr, int item, int lane, bool winmap) {
    const int kb = item / NB, nb = item % NB, k0 = 64 * kb, n0 = 32 * nb;
    const int np = n0 + 2 * (lane & 15);
    const int src = winmap ? win_src(np) : np;
    const int src1 = winmap ? win_src(np + 1) : np + 1;
    f32x2 v[16];
    const bool pairok = src >= 0 && src1 == src + 1;
    if (__builtin_amdgcn_ballot_w64(!pairok) == 0ull) {
#pragma unroll
        for (int i = 0; i < 16; ++i) { const int kk = 4 * i + (lane >> 4); v[i] = *(const f32x2*)(W + (size_t)(k0 + kk) * N + src); }
    } else {
#pragma unroll
        for (int i = 0; i < 16; ++i) { const int kk = 4 * i + (lane >> 4);
            const float xa = W[(size_t)(k0 + kk) * N + (src >= 0 ? src : 0)], xb = W[(size_t)(k0 + kk) * N + (src1 >= 0 ? src1 : 0)];
            v[i].x = (src >= 0) ? xa : 0.f; v[i].y = (src1 >= 0) ? xb : 0.f; }
    }
#pragma unroll
    for (int i = 0; i < 16; ++i) { const int kk = 4 * i + (lane >> 4); scr[kk * 33 + 2 * (lane & 15)] = v[i].x; scr[kk * 33 + 2 * (lane & 15) + 1] = v[i].y; }
    LDS_FENCE();
    const int c = lane & 7;
#pragma unroll
    for (int j = 0; j < 4; ++j) { const int n = (lane >> 3) + 8 * j; const float* s = scr + (8 * c) * 33 + n;
        u32x4 o; o.x = pk2(s[0 * 33], s[1 * 33]); o.y = pk2(s[2 * 33], s[3 * 33]); o.z = pk2(s[4 * 33], s[5 * 33]); o.w = pk2(s[6 * 33], s[7 * 33]);
        *(u32x4*)(WT + (size_t)(n0 + n) * K + k0 + 8 * c) = o; }
    LDS_FENCE();
}
__device__ __forceinline__ void rmsnorm_row_bf16(const float* xr, const float* g, bf16_t* o, int lane) {
    f32x4 v[8], gv[8]; float s = 0.f;
#pragma unroll
    for (int j = 0; j < 8; ++j) { v[j] = ((const f32x4*)xr)[lane + 64 * j]; gv[j] = ((const f32x4*)g)[lane + 64 * j]; }
#pragma unroll
    for (int j = 0; j < 8; ++j) s += (v[j].x * v[j].x + v[j].y * v[j].y) + (v[j].z * v[j].z + v[j].w * v[j].w);
    const float r = rsqrtf(wave_sum(s, lane) * (1.f / DM) + 1e-6f);
#pragma unroll
    for (int j = 0; j < 8; ++j) { const f32x4 gg = gv[j]; u32x2 w; w.x = pk2(v[j].x * r * gg.x, v[j].y * r * gg.y); w.y = pk2(v[j].z * r * gg.z, v[j].w * r * gg.w);
        ((u32x2*)o)[lane + 64 * j] = w; }
}

__device__ __forceinline__ void phase_prologue(ArgsP a, const int tid, unsigned char* lds) {
    const int lane = tid & 63, wave = tid >> 6, G = gridDim.x;
    float* scr = (float*)lds + wave * (64 * 33);
    const int gw = blockIdx.x * 8 + wave, NGW = G * 8;
    constexpr int I_IN = 32 * 208, I_SQ = 32 * 64, I_PW = 8 * 16, I_L = I_IN + 2 * I_SQ + I_PW;
    for (int it = gw; it < 2 * I_L; it += NGW) {
        const int l = it / I_L; int r = it % I_L;
        if (r < I_IN) { transpose_item(a->in[I_WIN] + (size_t)l * DM * 6414, DM, 6414, (bf16_t*)(a->ws + WS_WIN) + (size_t)l * ZLD * DM, 208, scr, r, lane, true); continue; } r -= I_IN;
        if (r < I_SQ) { transpose_item(a->in[I_WOUT] + (size_t)l * DM * DM, DM, DM, (bf16_t*)(a->ws + WS_WOUT) + (size_t)l * DM * DM, 64, scr, r, lane, false); continue; } r -= I_SQ;
        if (r < I_SQ) { transpose_item(a->in[I_PWQ] + (size_t)l * DM * DM, DM, DM, (bf16_t*)(a->ws + WS_WQ) + (size_t)l * DM * DM, 64, scr, r, lane, false); continue; } r -= I_SQ;
        transpose_item(a->in[I_CPWW] + (size_t)l * C_W * C_W, C_W, C_W, (bf16_t*)(a->ws + WS_WPW) + (size_t)l * C_W * C_W, 16, scr, r, lane, false);
    }
    for (int m = gw; m < NTOK; m += NGW) rmsnorm_row_bf16(a->in[I_X] + (size_t)m * DM, a->in[I_N1G], (bf16_t*)(a->ws + WS_HN) + (size_t)m * DM, lane);
    for (int i = blockIdx.x * 512 + tid; i < 2 * P_H * 2 * N_KEYS * 128 / 8; i += G * 512) {
        const f32x4 x0 = ((const f32x4*)a->in[I_PKEYS])[2 * i], x1 = ((const f32x4*)a->in[I_PKEYS])[2 * i + 1];
        const unsigned h0 = f2bf(x0.x), h1 = f2bf(x0.y), h2 = f2bf(x0.z), h3 = f2bf(x0.w), h4 = f2bf(x1.x), h5 = f2bf(x1.y), h6 = f2bf(x1.z), h7 = f2bf(x1.w);
        u32x4 wh, wl; wh.x = h0 | (h1 << 16); wh.y = h2 | (h3 << 16); wh.z = h4 | (h5 << 16); wh.w = h6 | (h7 << 16);
        wl.x = pk2(x0.x - bf_lo(h0), x0.y - bf_lo(h1)); wl.y = pk2(x0.z - bf_lo(h2), x0.w - bf_lo(h3)); wl.z = pk2(x1.x - bf_lo(h4), x1.y - bf_lo(h5)); wl.w = pk2(x1.z - bf_lo(h6), x1.w - bf_lo(h7));
        ((u32x4*)(a->ws + WS_KH))[i] = wh; ((u32x4*)(a->ws + WS_KL))[i] = wl;
    }
}

__device__ __forceinline__ void phase_gateprep(ArgsP a, const int tid, int layer, unsigned char* lds, const int bh) {
    const int lane = tid & 63, wave = tid >> 6;
    if (bh < 0 || bh >= 12) return;
    const int b = bh / A_H, h = bh % A_H;
    const float* gate = (const float*)(a->ws + WS_GATE);
    float* cf = (float*)(a->ws + WS_CFOX) + (size_t)bh * SEQ;
    float* wtot = (float*)lds;
    const float fb = a->in[I_FOXB][layer * A_H + h];
    float v[8]; float s = 0.f;
#pragma unroll
    for (int i = 0; i < 8; ++i) { v[i] = log_sigmoidf_(gate[(size_t)(b * SEQ + tid * 8 + i) * 16 + h] + fb); s += v[i]; }
    float incl = s;
#pragma unroll
    for (int o = 1; o < 64; o <<= 1) { const float t = SHUP(incl, o); if (lane >= o) incl += t; }
    __syncthreads();
    if (lane == 63) wtot[wave] = incl;
    __syncthreads();
    float run = incl - s;
#pragma unroll
    for (int w = 0; w < 8; ++w) if (w < wave) run += wtot[w];
    f32x4 o0, o1;
    run += v[0]; o0.x = run; run += v[1]; o0.y = run; run += v[2]; o0.z = run; run += v[3]; o0.w = run;
    run += v[4]; o1.x = run; run += v[5]; o1.y = run; run += v[6]; o1.z = run; run += v[7]; o1.w = run;
    *(f32x4*)(cf + tid * 8) = o0; *(f32x4*)(cf + tid * 8 + 4) = o1;
}

typedef short bf16x8 __attribute__((ext_vector_type(8)));
typedef short s16x4 __attribute__((ext_vector_type(4)));
constexpr int MSTR = 200;
constexpr int PSTR = 72;
constexpr size_t WS_MDC = 512 * MiB;
constexpr size_t WS_MDN = 552 * MiB;
constexpr size_t WS_MSC = 553 * MiB;
constexpr size_t WS_MKC = 448 * MiB;
__device__ __forceinline__ s16x4 tr16(const bf16_t* p) {
    return __builtin_bit_cast(s16x4, __builtin_amdgcn_ds_read_tr16_b64_v4i16((__attribute__((address_space(3))) s16x4*)p));
}
__device__ __forceinline__ bf16x8 cat8(s16x4 lo, s16x4 hi) { return (bf16x8){lo[0], lo[1], lo[2], lo[3], hi[0], hi[1], hi[2], hi[3]}; }
__device__ __forceinline__ void unpack8(const u32x4 w, float (&f)[8]) { f[0] = bf_lo(w.x); f[1] = bf_hi(w.x); f[2] = bf_lo(w.y); f[3] = bf_hi(w.y); f[4] = bf_lo(w.z); f[5] = bf_hi(w.z); f[6] = bf_lo(w.w); f[7] = bf_hi(w.w); }
__device__ __forceinline__ void conv8_silu(const bf16_t* zrow, int t, int zc, const float* cw, float (&o)[8], const bool full) {
#pragma unroll
    for (int i = 0; i < 8; ++i) o[i] = 0.f;
    if (full) {
        u32x4 xr[4]; f32x4 w0[4], w1[4];
#pragma unroll
        for (int j = 0; j < 4; ++j) { xr[j] = *(const u32x4*)(zrow - (size_t)(3 - j) * ZLD + zc); w0[j] = *(const f32x4*)(cw + j * 1536); w1[j] = *(const f32x4*)(cw + j * 1536 + 4); }
#pragma unroll
        for (int j = 0; j < 4; ++j) {
            float x[8]; unpack8(xr[j], x);
            o[0] += w0[j].x * x[0]; o[1] += w0[j].y * x[1]; o[2] += w0[j].z * x[2]; o[3] += w0[j].w * x[3]; o[4] += w1[j].x * x[4]; o[5] += w1[j].y * x[5]; o[6] += w1[j].z * x[6]; o[7] += w1[j].w * x[7];
        }
    } else
#pragma unroll
    for (int j = 0; j < 4; ++j) {
        if (t - 3 + j >= 0) {
            float x[8]; unpack8(*(const u32x4*)(zrow - (size_t)(3 - j) * ZLD + zc), x);
            const f32x4 w0 = *(const f32x4*)(cw + j * 1536), w1 = *(const f32x4*)(cw + j * 1536 + 4);
            o[0] += w0.x * x[0]; o[1] += w0.y * x[1]; o[2] += w0.z * x[2]; o[3] += w0.w * x[3]; o[4] += w1.x * x[4]; o[5] += w1.y * x[5]; o[6] += w1.z * x[6]; o[7] += w1.w * x[7];
        }
    }
#pragma unroll
    for (int i = 0; i < 8; ++i) o[i] = o[i] * sigmoidf_(o[i]);
}
__device__ __forceinline__ u32x4 pack8f(const float (&f)[8], float s) { u32x4 w; w.x = pk2(f[0] * s, f[1] * s); w.y = pk2(f[2] * s, f[3] * s); w.z = pk2(f[4] * s, f[5] * s); w.w = pk2(f[6] * s, f[7] * s); return w; }

__device__ __forceinline__ void mlstm_b1_item(ArgsP a, const int tid, int layer, unsigned char* lds, int item) {
    const int lane = tid & 63, wave = __builtin_amdgcn_readfirstlane(tid >> 6);
    const int bh = item >> 6, c = item & 63, b = bh >> 2, h = bh & 3;
    const size_t tok0 = (size_t)b * SEQ + c * 64;
    bf16_t* KS = (bf16_t*)lds; bf16_t* VS = KS + 64 * MSTR; float* wts = (float*)(VS + 64 * MSTR);
    unsigned char* ws = a->ws;
    const bf16_t* Z = (const bf16_t*)(ws + WS_Z);
    const float* gate = (const float*)(ws + WS_GATE);
    float* MSC = (float*)(ws + WS_MSC);
    __syncthreads();
    if (wave == 0) {
        __builtin_amdgcn_s_setprio(1);
        const float li = gate[(tok0 + lane) * 16 + 6 + h] + a->in[I_MIB][layer * B_H + h];
        const float lf = log_sigmoidf_(gate[(tok0 + lane) * 16 + 10 + h] + a->in[I_MFB][layer * B_H + h]);
        float bc = lf;
#pragma unroll
        for (int o = 1; o < 64; o <<= 1) { const float t = SHUP(bc, o); if (lane >= o) bc += t; }
        const float blast = RDLANE(bc, 63);
        const float dec = blast - bc + li;
        const float mloc = wave_max(dec, lane);
        wts[lane] = __expf(dec - mloc);
        if (lane == 0) { MSC[item] = mloc; MSC[512 + item] = blast; }
        __builtin_amdgcn_s_setprio(0);
    }
    __syncthreads();
    {
        const float* cwk = a->in[I_MCONVW] + (size_t)layer * 4 * 1536 + 768 + h * B_D;
#pragma unroll
        for (int o = 0; o < 3; ++o) {
            const int idx = tid + 512 * o, s = idx / 24, ch = (idx % 24) * 8, t = c * 64 + s;
            const bf16_t* zrow = Z + (tok0 + s) * ZLD;
            float kv[8]; conv8_silu(zrow, t, ZC_BQK + 768 + h * B_D + ch, cwk + ch, kv, c > 0);
            *(u32x4*)(KS + s * MSTR + ch) = pack8f(kv, wts[s]);
            *(u32x4*)((bf16_t*)(ws + WS_MKC) + ((size_t)item * 64 + s) * B_D + ch) = pack8f(kv, 1.f);
            *(u32x4*)(VS + s * MSTR + ch) = *(const u32x4*)(zrow + ZC_BV + h * B_D + ch);
        }
    }
    __syncthreads();
    if (tid < B_D) { float dn = 0.f;
#pragma unroll
        for (int s0 = 0; s0 < 64; s0 += 16) { bf16_t t16[16];
#pragma unroll
            for (int k = 0; k < 16; ++k) t16[k] = KS[(s0 + k) * MSTR + tid];
            asm volatile("" ::: "memory");
            float p0 = 0.f, p1 = 0.f, p2 = 0.f, p3 = 0.f;
#pragma unroll
            for (int k = 0; k < 4; ++k) { p0 += bf2f(t16[4 * k]); p1 += bf2f(t16[4 * k + 1]); p2 += bf2f(t16[4 * k + 2]); p3 += bf2f(t16[4 * k + 3]); }
            dn += (p0 + p1) + (p2 + p3); }
        ((float*)(ws + WS_MDN))[(size_t)item * B_D + tid] = dn; }
    const int i16 = lane & 15, g4 = lane >> 4;
    bf16_t* DC = (bf16_t*)(ws + WS_MDC) + (size_t)item * B_D * B_D;
    for (int i = 0; i < 18; ++i) {
        const int idx = wave + 8 * i, dt = idx / 12, et = idx % 12;
        f32x4 acc = (f32x4){0.f, 0.f, 0.f, 0.f};
#pragma unroll
        for (int ks = 0; ks < 2; ++ks) {
            const int s0 = 32 * ks + 8 * g4 + (i16 >> 2), cc = 4 * (i16 & 3);
            const bf16x8 A = cat8(tr16(KS + s0 * MSTR + 16 * dt + cc), tr16(KS + (s0 + 4) * MSTR + 16 * dt + cc));
            const bf16x8 B = cat8(tr16(VS + s0 * MSTR + 16 * et + cc), tr16(VS + (s0 + 4) * MSTR + 16 * et + cc));
            acc = __builtin_amdgcn_mfma_f32_16x16x32_bf16(A, B, acc, 0, 0, 0);
        }
        u32x2 w; w.x = pk2(acc[0], acc[1]); w.y = pk2(acc[2], acc[3]);
        *(u32x2*)(DC + (size_t)(16 * et + i16) * B_D + 16 * dt + 4 * g4) = w;
    }
}

constexpr int NSCAN = 8 * B_D * 48 / 512;
__device__ __forceinline__ void mlstm_scan_piece(ArgsP a, const int tid, unsigned char* lds, int idx) {
    unsigned char* ws = a->ws;
    const float* MSC = (const float*)(ws + WS_MSC);
    float* msc_s = (float*)lds;
    float* coef = msc_s + 256;
    float* mns = coef + 256;
    const int it0 = idx * 512, bh0 = it0 / (B_D * 48), bh1 = (it0 + 511) / (B_D * 48);
    __syncthreads();
    if (tid < 256) { const int t2 = tid >> 7, k = tid & 127, bh = t2 ? bh1 : bh0; msc_s[tid] = MSC[(k >> 6) * 512 + bh * 64 + (k & 63)]; }
    __syncthreads();
    if (tid < 2) { float mm = 0.f;
#pragma unroll 1
        for (int c = 0; c < 64; ++c) { const float mloc = msc_s[tid * 128 + c], bl = msc_s[tid * 128 + 64 + c];
            const float mn = fmaxf(bl + mm, mloc); coef[(tid * 64 + c) * 2] = __expf(bl + mm - mn); coef[(tid * 64 + c) * 2 + 1] = __expf(mloc - mn); mns[tid * 64 + c] = mn; mm = mn; } }
    __syncthreads();
    const int it = it0 + tid, bh = it / (B_D * 48), rem = it % (B_D * 48);
    const float* cf = coef + (bh - bh0) * 128;
    {
        u32x2* p = (u32x2*)((bf16_t*)(ws + WS_MDC) + (size_t)bh * 64 * B_D * B_D) + rem;
        f32x4 C = (f32x4){0.f, 0.f, 0.f, 0.f};
#pragma unroll 1
        for (int hb = 0; hb < 2; ++hb) {
            u32x2 x[32];
#pragma unroll
            for (int c = 0; c < 32; ++c) x[c] = p[(size_t)(32 * hb + c) * (B_D * B_D / 4)];
#pragma unroll
            for (int c = 0; c < 32; ++c) { const float aa = cf[2 * (32 * hb + c)], ww = cf[2 * (32 * hb + c) + 1];
                C.x = aa * C.x + ww * bf_lo(x[c].x); C.y = aa * C.y + ww * bf_hi(x[c].x); C.z = aa * C.z + ww * bf_lo(x[c].y); C.w = aa * C.w + ww * bf_hi(x[c].y);
                x[c].x = pk2(C.x, C.y); x[c].y = pk2(C.z, C.w); }
#pragma unroll
            for (int c = 0; c < 32; ++c) p[(size_t)(32 * hb + c) * (B_D * B_D / 4)] = x[c];
            asm volatile("" ::: "memory");
        }
    }
    if (rem < B_D) {
        float* pn = (float*)(ws + WS_MDN) + (size_t)bh * 64 * B_D + rem;
        float n = 0.f;
#pragma unroll 1
        for (int hb = 0; hb < 2; ++hb) {
            float xn[32];
#pragma unroll
            for (int c = 0; c < 32; ++c) xn[c] = pn[(32 * hb + c) * B_D];
#pragma unroll
            for (int c = 0; c < 32; ++c) { n = cf[2 * (32 * hb + c)] * n + cf[2 * (32 * hb + c) + 1] * xn[c]; xn[c] = n; }
#pragma unroll
            for (int c = 0; c < 32; ++c) pn[(32 * hb + c) * B_D] = xn[c];
            asm volatile("" ::: "memory");
        }
        if (rem < 64) ((float*)(ws + WS_MSC) + 1024)[bh * 64 + rem] = mns[(bh - bh0) * 64 + rem];
    }
}

__device__ __forceinline__ void mlstm_out_item(ArgsP a, const int tid, int layer, unsigned char* lds, int item) {
    const int lane = tid & 63, wave = __builtin_amdgcn_readfirstlane(tid >> 6);
    const int bh = item >> 6, c = item & 63, b = bh >> 2, h = bh & 3;
    const size_t tok0 = (size_t)b * SEQ + c * 64;
    bf16_t* QS = (bf16_t*)lds; bf16_t* KS = QS + 64 * MSTR; bf16_t* VS = KS + 64 * MSTR; bf16_t* PS = VS + 64 * MSTR;
    float* gA = (float*)(PS + 64 * PSTR); float* uA = gA + 64; float* winA = uA + 64; float* emtA = winA + 64; float* qnA = emtA + 64;
    float* RS = qnA + 64; float* SS = RS + 128; float* nprev = SS + 128;
    bf16_t* BS = (bf16_t*)(nprev + 192);
    unsigned char* ws = a->ws;
    const bf16_t* Z = (const bf16_t*)(ws + WS_Z);
    const float* gate = (const float*)(ws + WS_GATE);
    const float* MS = (const float*)(ws + WS_MSC) + 1024;
    __syncthreads();
    const float m_prev = (c > 0) ? MS[item - 1] : 0.f;
    if (wave == 0) {
        __builtin_amdgcn_s_setprio(1);
        const float li = gate[(tok0 + lane) * 16 + 6 + h] + a->in[I_MIB][layer * B_H + h];
        const float lf = log_sigmoidf_(gate[(tok0 + lane) * 16 + 10 + h] + a->in[I_MFB][layer * B_H + h]);
        float bc = lf;
#pragma unroll
        for (int o = 1; o < 64; o <<= 1) { const float t = SHUP(bc, o); if (lane >= o) bc += t; }
        const float g = li - bc;
        float M = g;
#pragma unroll
        for (int o = 1; o < 64; o <<= 1) { const float t = SHUP(M, o); if (lane >= o) M = fmaxf(M, t); }
        const float u = fmaxf(m_prev, M);
        gA[lane] = g; uA[lane] = u; winA[lane] = __expf(m_prev - u); emtA[lane] = __expf(-(bc + u));
        __builtin_amdgcn_s_setprio(0);
    }
    if (tid >= 64 && tid < 64 + B_D) nprev[tid - 64] = (c > 0) ? ((const float*)(ws + WS_MDN))[(size_t)(item - 1) * B_D + tid - 64] : 0.f;
    {
        const float* cwq = a->in[I_MCONVW] + (size_t)layer * 4 * 1536 + h * B_D;
#pragma unroll
        for (int o = 0; o < 3; ++o) {
            const int idx = tid + 512 * o, s = idx / 24, ch = (idx % 24) * 8, t = c * 64 + s;
            const bf16_t* zrow = Z + (tok0 + s) * ZLD;
            float qv[8]; conv8_silu(zrow, t, ZC_BQK + h * B_D + ch, cwq + ch, qv, c > 0);
            *(u32x4*)(QS + s * MSTR + ch) = pack8f(qv, 0.07216878364870322f);
            *(u32x4*)(KS + s * MSTR + ch) = *(const u32x4*)((const bf16_t*)(ws + WS_MKC) + ((size_t)item * 64 + s) * B_D + ch);
            *(u32x4*)(VS + s * MSTR + ch) = *(const u32x4*)(zrow + ZC_BV + h * B_D + ch);
            *(u32x4*)(BS + s * MSTR + ch) = *(const u32x4*)(zrow + ZC_BO + h * B_D + ch);
        }
    }
    __syncthreads();
    {
        const int t = tid >> 3, part = tid & 7; float acc = 0.f;
        { u32x4 qw[3]; f32x4 nv[6];
#pragma unroll
          for (int k = 0; k < 3; ++k) qw[k] = *(const u32x4*)(QS + t * MSTR + part * 24 + 8 * k);
#pragma unroll
          for (int k = 0; k < 6; ++k) nv[k] = *(const f32x4*)(nprev + part * 24 + 4 * k);
#pragma unroll
          for (int k = 0; k < 3; ++k) { float q8[8]; unpack8(qw[k], q8);
              acc += (q8[0] * nv[2 * k].x + q8[1] * nv[2 * k].y) + (q8[2] * nv[2 * k].z + q8[3] * nv[2 * k].w) + (q8[4] * nv[2 * k + 1].x + q8[5] * nv[2 * k + 1].y) + (q8[6] * nv[2 * k + 1].z + q8[7] * nv[2 * k + 1].w); } }
        acc += SHX(acc, 1); acc += SHX(acc, 2); acc += SHX(acc, 4);
        if (part == 0) qnA[t] = acc;
    }
    const int i16 = lane & 15, g4 = lane >> 4;
    const int r = wave & 3, hf = wave >> 2;
    {
        float rowp[4] = {0.f, 0.f, 0.f, 0.f};
#pragma unroll
        for (int ci = 0; ci < 2; ++ci) {
            const int ct = 2 * hf + ci;
            f32x4 acc = (f32x4){0.f, 0.f, 0.f, 0.f};
#pragma unroll
            for (int ks = 0; ks < 6; ++ks) {
                const bf16x8 A = *(const bf16x8*)(QS + (16 * r + i16) * MSTR + 32 * ks + 8 * g4);
                const bf16x8 B = *(const bf16x8*)(KS + (16 * ct + i16) * MSTR + 32 * ks + 8 * g4);
                acc = __builtin_amdgcn_mfma_f32_16x16x32_bf16(A, B, acc, 0, 0, 0);
            }
            const int s = 16 * ct + i16; const float gs = gA[s];
#pragma unroll
            for (int rg = 0; rg < 4; ++rg) { const int t = 16 * r + 4 * g4 + rg;
                const float val = (s <= t) ? acc[rg] * __expf(gs - uA[t]) : 0.f;
                PS[t * PSTR + s] = (bf16_t)f2bf(val); rowp[rg] += val; }
        }
#pragma unroll
        for (int rg = 0; rg < 4; ++rg) { const float v = rowsum16_dpp(rowp[rg]);
            if (i16 == 15) RS[hf * 64 + 16 * r + 4 * g4 + rg] = v; }
    }
    __syncthreads();
    f32x4 acc[6];
#pragma unroll
    for (int j = 0; j < 6; ++j) acc[j] = (f32x4){0.f, 0.f, 0.f, 0.f};
    if (c > 0) {
        const bf16_t* CS = (const bf16_t*)(ws + WS_MDC) + (size_t)(item - 1) * B_D * B_D;
#pragma unroll
        for (int ks = 0; ks < 6; ++ks) {
            bf16x8 Bf[6];
#pragma unroll
            for (int j = 0; j < 6; ++j) Bf[j] = *(const bf16x8*)(CS + (size_t)(96 * hf + 16 * j + i16) * B_D + 32 * ks + 8 * g4);
            const bf16x8 A = *(const bf16x8*)(QS + (16 * r + i16) * MSTR + 32 * ks + 8 * g4);
#pragma unroll
            for (int j = 0; j < 6; ++j) acc[j] = __builtin_amdgcn_mfma_f32_16x16x32_bf16(A, Bf[j], acc[j], 0, 0, 0);
            asm volatile("" ::: "memory");
        }
#pragma unroll
        for (int rg = 0; rg < 4; ++rg) { const float wi = winA[16 * r + 4 * g4 + rg];
#pragma unroll
            for (int j = 0; j < 6; ++j) acc[j][rg] *= wi; }
    }
#pragma unroll
    for (int ks = 0; ks < 2; ++ks) {
        const bf16x8 A = *(const bf16x8*)(PS + (16 * r + i16) * PSTR + 32 * ks + 8 * g4);
        const int s0 = 32 * ks + 8 * g4 + (i16 >> 2), cc = 4 * (i16 & 3);
#pragma unroll
        for (int j = 0; j < 6; ++j) {
            const bf16x8 B = cat8(tr16(VS + s0 * MSTR + 96 * hf + 16 * j + cc), tr16(VS + (s0 + 4) * MSTR + 96 * hf + 16 * j + cc));
            acc[j] = __builtin_amdgcn_mfma_f32_16x16x32_bf16(A, B, acc[j], 0, 0, 0);
        }
    }
    float sq[4];
#pragma unroll
    for (int rg = 0; rg < 4; ++rg) { const int t = 16 * r + 4 * g4 + rg;
        const float den = winA[t] * qnA[t] + RS[t] + RS[64 + t];
        const float inv = 1.f / fmaxf(fabsf(den), emtA[t]);
        float s2 = 0.f;
#pragma unroll
        for (int j = 0; j < 6; ++j) { const int e = 96 * hf + 16 * j + i16;
            const float bo = bf2f(BS[t * MSTR + e]);
            const float yb = sigmoidf_(bo) * acc[j][rg] * inv; acc[j][rg] = yb; s2 += yb * yb; }
        s2 = rowsum16_dpp(s2);
        sq[rg] = s2;
        if (i16 == 15) SS[hf * 64 + t] = s2; }
    __syncthreads();
    bf16_t* Y = (bf16_t*)(ws + WS_Y);
    const float* ong = a->in[I_ONG] + layer * DM + 768 + h * B_D;
    bf16_t* YS = QS;
#pragma unroll
    for (int rg = 0; rg < 4; ++rg) { const int t = 16 * r + 4 * g4 + rg;
        const float rr = rsqrtf((SS[t] + SS[64 + t]) * (1.f / B_D) + 1e-6f);
#pragma unroll
        for (int j = 0; j < 6; ++j) { const int e = 96 * hf + 16 * j + i16;
            YS[t * MSTR + e] = (bf16_t)f2bf(acc[j][rg] * rr * ong[e]); } }
    __syncthreads();
    { const int row = tid >> 3, c0 = (tid & 7) * 24;
#pragma unroll
      for (int q = 0; q < 3; ++q) *(u32x4*)(Y + (tok0 + row) * DM + 768 + h * B_D + c0 + 8 * q) = *(const u32x4*)(YS + row * MSTR + c0 + 8 * q); }
    (void)sq;
}
typedef float f32x16 __attribute__((ext_vector_type(16)));
constexpr int AKSTR = 136;
constexpr int ATT_KV_BYTES = 64 * AKSTR * 2;
constexpr int ATT_ITEMS = 12 * 32;
constexpr int ATT_QREG = 4;
__device__ __forceinline__ void attn_item(ArgsP a, const int tid, int layer, unsigned char* lds, int bh, int qb) {
    const int lane = tid & 63, wave = __builtin_amdgcn_readfirstlane(tid >> 6), grp = wave >> 2, wq = wave & 3;
    const int b = bh / A_H, h = bh % A_H;
    const int l31 = lane & 31, hh = lane >> 5, i16 = lane & 15, g4 = lane >> 4;
    unsigned char* ws = a->ws;
    const bf16_t* Z = (const bf16_t*)(ws + WS_Z);
    const float* CF = (const float*)(ws + WS_CFOX) + (size_t)bh * SEQ;
    const size_t tokb = (size_t)b * SEQ;
    const int q0 = 128 * qb + 32 * wq;
    bf16_t* KS = (bf16_t*)lds;
    bf16_t* VS = (bf16_t*)(lds + 2 * ATT_KV_BYTES);
    float* CB = (float*)(lds + 4 * ATT_KV_BYTES);
    bf16_t* QS = (bf16_t*)(lds + 4 * ATT_KV_BYTES + 1024);
    const float C2 = 0.12751743f, LOG2E = 1.4426950408889634f;
    f32x16 O[4];
#pragma unroll
    for (int dt = 0; dt < 4; ++dt)
#pragma unroll
        for (int r = 0; r < 16; ++r) O[dt][r] = 0.f;
    float m = -1e30f, l = 0.f;
    u32x4 st[8]; float cbr = 0.f;
    const int srow0 = tid >> 4, sch = tid & 15;
    __syncthreads();
    if (grp == 0) { const bf16_t* qp = Z + (tokb + q0 + l31) * ZLD + ZC_AQ + h * A_D + 8 * hh;
#pragma unroll
      for (int ks = 0; ks < 8; ++ks) *(bf16x8*)(QS + (32 * wq + l31) * AKSTR + 16 * ks + 8 * hh) = *(const bf16x8*)(qp + 16 * ks); }
#define ATT_ISSUE(i) do { _Pragma("unroll") for (int tt = 0; tt < 2; ++tt) _Pragma("unroll") for (int rep = 0; rep < 2; ++rep) { \
        const bf16_t* p = Z + (tokb + 64 * (2 * (i) + tt) + srow0 + 32 * rep) * ZLD + h * A_D + 8 * sch; \
        st[tt * 4 + rep] = *(const u32x4*)(p + ZC_AK); st[tt * 4 + 2 + rep] = *(const u32x4*)(p + ZC_AV); } \
        if (tid < 128) cbr = -CF[64 * (2 * (i)) + tid] * LOG2E; } while (0)
#define ATT_WRITE_K(i) do { _Pragma("unroll") for (int tt = 0; tt < 2; ++tt) _Pragma("unroll") for (int rep = 0; rep < 2; ++rep) \
        *(u32x4*)(KS + tt * 64 * AKSTR + (srow0 + 32 * rep) * AKSTR + 8 * sch) = st[tt * 4 + rep]; \
        if (tid < 128) CB[((i) & 1) * 128 + tid] = cbr; } while (0)
#define ATT_WRITE_V() do { _Pragma("unroll") for (int tt = 0; tt < 2; ++tt) _Pragma("unroll") for (int rep = 0; rep < 2; ++rep) \
        *(u32x4*)(VS + tt * 64 * AKSTR + (srow0 + 32 * rep) * AKSTR + 8 * sch) = st[tt * 4 + 2 + rep]; } while (0)
    ATT_ISSUE(0); ATT_WRITE_K(0); ATT_WRITE_V();
    __syncthreads();
    const bf16_t* Kt = KS + grp * 64 * AKSTR; const bf16_t* Vt = VS + grp * 64 * AKSTR;
    bf16x8 qreg[ATT_QREG];
#pragma unroll
    for (int ks = 0; ks < ATT_QREG; ++ks) qreg[ks] = *(const bf16x8*)(QS + (32 * wq + l31) * AKSTR + 16 * ks + 8 * hh);
    for (int i = 0; i <= qb; ++i) {
        const float* cb = CB + (i & 1) * 128 + grp * 64;
        if (i < qb) ATT_ISSUE(i + 1);
        f32x16 s0, s1;
#pragma unroll
        for (int r = 0; r < 16; ++r) { s0[r] = 0.f; s1[r] = 0.f; }
#pragma unroll
        for (int ks = 0; ks < 8; ++ks) {
            const bf16x8 A0 = *(const bf16x8*)(Kt + l31 * AKSTR + 16 * ks + 8 * hh);
            const bf16x8 A1 = *(const bf16x8*)(Kt + (32 + l31) * AKSTR + 16 * ks + 8 * hh);
            const bf16x8 qk = ks < ATT_QREG ? qreg[ks < ATT_QREG ? ks : 0] : *(const bf16x8*)(QS + (32 * wq + l31) * AKSTR + 16 * ks + 8 * hh);
            s0 = __builtin_amdgcn_mfma_f32_32x32x16_bf16(A0, qk, s0, 0, 0, 0);
            s1 = __builtin_amdgcn_mfma_f32_32x32x16_bf16(A1, qk, s1, 0, 0, 0);
        }
        __syncthreads();
        if (i < qb) ATT_WRITE_K(i + 1);
#pragma unroll
        for (int g = 0; g < 4; ++g) { const f32x4 c0 = *(const f32x4*)(cb + 8 * g + 4 * hh), c1 = *(const f32x4*)(cb + 32 + 8 * g + 4 * hh);
#pragma unroll
            for (int e = 0; e < 4; ++e) { s0[4 * g + e] = s0[4 * g + e] * C2 + c0[e]; s1[4 * g + e] = s1[4 * g + e] * C2 + c1[e]; } }
        if (i == qb) {
            const int dq = (q0 + l31) - (64 * (2 * i + grp) + 4 * hh);
#pragma unroll
            for (int r = 0; r < 16; ++r) { const int kr = (r & 3) + 8 * (r >> 2);
                if (kr > dq) s0[r] = -__builtin_inff();
                if (kr + 32 > dq) s1[r] = -__builtin_inff(); }
        }
        float mx = s0[0];
#pragma unroll
        for (int r = 1; r < 16; ++r) mx = fmaxf(mx, s0[r]);
#pragma unroll
        for (int r = 0; r < 16; ++r) mx = fmaxf(mx, s1[r]);
        mx = fmaxf(mx, SHX(mx, 32));
        const float mn = fmaxf(m, mx);
        const float alpha = __builtin_amdgcn_exp2f(m - mn);
        m = mn;
        float ls = 0.f;
#pragma unroll
        for (int r = 0; r < 16; ++r) { s0[r] = __builtin_amdgcn_exp2f(s0[r] - mn); s1[r] = __builtin_amdgcn_exp2f(s1[r] - mn); ls += s0[r] + s1[r]; }
        l = l * alpha + ls;
#pragma unroll
        for (int dt = 0; dt < 4; ++dt)
#pragma unroll
            for (int r = 0; r < 16; ++r) O[dt][r] *= alpha;
#pragma unroll
        for (int sub = 0; sub < 2; ++sub)
#pragma unroll
            for (int k2 = 0; k2 < 2; ++k2) {
                u32x4 pw;
                if (sub == 0) { pw.x = pg8::cvt_pk_bf16(s0[8 * k2 + 0], s0[8 * k2 + 1]); pw.y = pg8::cvt_pk_bf16(s0[8 * k2 + 2], s0[8 * k2 + 3]); pw.z = pg8::cvt_pk_bf16(s0[8 * k2 + 4], s0[8 * k2 + 5]); pw.w = pg8::cvt_pk_bf16(s0[8 * k2 + 6], s0[8 * k2 + 7]); }
                else          { pw.x = pg8::cvt_pk_bf16(s1[8 * k2 + 0], s1[8 * k2 + 1]); pw.y = pg8::cvt_pk_bf16(s1[8 * k2 + 2], s1[8 * k2 + 3]); pw.z = pg8::cvt_pk_bf16(s1[8 * k2 + 4], s1[8 * k2 + 5]); pw.w = pg8::cvt_pk_bf16(s1[8 * k2 + 6], s1[8 * k2 + 7]); }
                const bf16x8 P = __builtin_bit_cast(bf16x8, pw);
                const bf16_t* vb = Vt + (32 * sub + 16 * k2 + 4 * hh + (i16 >> 2)) * AKSTR + 16 * (g4 & 1) + 4 * (i16 & 3);
#pragma unroll
                for (int dt = 0; dt < 4; ++dt) {
                    const bf16x8 Av = cat8(tr16(vb + 32 * dt), tr16(vb + 8 * AKSTR + 32 * dt));
                    O[dt] = __builtin_amdgcn_mfma_f32_32x32x16_bf16(Av, P, O[dt], 0, 0, 0);
                }
            }
        __syncthreads();
        if (i < qb) ATT_WRITE_V();
    }
#undef ATT_ISSUE
#undef ATT_WRITE_K
#undef ATT_WRITE_V
    l += SHX(l, 32);
    float* MB = (float*)lds;
    float* ML = MB + 4 * 64 * 64;
    if (grp == 1) {
#pragma unroll
        for (int dt = 0; dt < 4; ++dt)
#pragma unroll
            for (int r = 0; r < 16; ++r) MB[(wq * 64 + dt * 16 + r) * 64 + lane] = O[dt][r];
        ML[(wq * 2) * 64 + lane] = m; ML[(wq * 2 + 1) * 64 + lane] = l;
    }
    __syncthreads();
    if (grp == 0) {
        const float m1 = ML[(wq * 2) * 64 + lane], l1 = ML[(wq * 2 + 1) * 64 + lane];
        const float mm = fmaxf(m, m1), w0 = __builtin_amdgcn_exp2f(m - mm), w1 = __builtin_amdgcn_exp2f(m1 - mm);
        const float inv = 1.f / (l * w0 + l1 * w1);
        float ss = 0.f;
#pragma unroll
        for (int dt = 0; dt < 4; ++dt)
#pragma unroll
            for (int r = 0; r < 16; ++r) { const float o = (O[dt][r] * w0 + MB[(wq * 64 + dt * 16 + r) * 64 + lane] * w1) * inv; O[dt][r] = o; ss += o * o; }
        ss += SHX(ss, 32);
        const float rr = rsqrtf(ss * (1.f / A_D) + 1e-6f);
        bf16_t* yp = (bf16_t*)(ws + WS_Y) + (tokb + q0 + l31) * DM + h * A_D;
        const float* ong = a->in[I_ONG] + layer * DM + h * A_D;
#pragma unroll
        for (int dt = 0; dt < 4; ++dt) {
            f32x4 gq[4];
#pragma unroll
            for (int g = 0; g < 4; ++g) gq[g] = *(const f32x4*)(ong + 32 * dt + 8 * g + 4 * hh);
#pragma unroll
            for (int g = 0; g < 4; ++g) { const int d = 32 * dt + 8 * g + 4 * hh; const f32x4 gg = gq[g];
                u32x2 w; w.x = pk2(O[dt][4 * g] * rr * gg.x, O[dt][4 * g + 1] * rr * gg.y); w.y = pk2(O[dt][4 * g + 2] * rr * gg.z, O[dt][4 * g + 3] * rr * gg.w);
                *(u32x2*)(yp + d) = w; } }
    }
}
__device__ __forceinline__ void conv_front_tile(ArgsP a, const int tid, int layer, unsigned char* lds, int tile) {
    const int lane = tid & 63, wave = tid >> 6;
    float* glu = (float*)lds;
    float* part = glu + 62 * 512;
    float* stat = part + 32 * 16;
    const bf16_t* Z = (const bf16_t*)(a->ws + WS_Z);
    bf16_t* CA = (bf16_t*)(a->ws + WS_CACT);
    const float* dw = a->in[I_CDWW] + (size_t)layer * C_K * C_W;
    float w[C_K];
#pragma unroll
    for (int j = 0; j < C_K; ++j) w[j] = dw[j * C_W + tid];
    const float db = a->in[I_CDWB][layer * C_W + tid], lg = a->in[I_CLNG][layer * C_W + tid], lb = a->in[I_CLNB][layer * C_W + tid];
    {
        const int tok0 = tile * 32, t0 = tok0 % SEQ;
        __syncthreads();
#pragma unroll
        for (int r0 = 0; r0 < 64; r0 += 16) {
            unsigned short xa[16], xg[16];
#pragma unroll
            for (int k = 0; k < 16; ++k) if (r0 + k < 62) { const int back = 30 - (r0 + k); const bf16_t* zp = Z + (size_t)(tok0 - (back <= t0 ? back : t0)) * ZLD;
                xa[k] = zp[ZC_CA + tid]; xg[k] = zp[ZC_CG + tid]; }
#pragma unroll
            for (int k = 0; k < 16; ++k) if (r0 + k < 62) { const int r = r0 + k;
                const float ca = bf2f(xa[k]), cg = bf2f(xg[k]);
                glu[r * 512 + tid] = (t0 - 30 + r >= 0) ? ca * sigmoidf_(cg) : 0.f; }
        }
        __syncthreads();
        float yc[32];
#pragma unroll
        for (int tt = 0; tt < 32; ++tt) { float acc = db;
#pragma unroll
            for (int j = 0; j < C_K; ++j) acc += w[j] * glu[(tt + j) * 512 + tid];
            yc[tt] = acc; }
        {
            float s1[32], s2[32];
#pragma unroll
            for (int tt = 0; tt < 32; ++tt) { s1[tt] = yc[tt]; s2[tt] = yc[tt] * yc[tt]; }
#define CF_STEP(o_) { _Pragma("unroll") for (int tt = 0; tt < 32; ++tt) { s1[tt] += SHX(s1[tt], o_); s2[tt] += SHX(s2[tt], o_); } asm volatile("" ::: "memory"); }
            CF_STEP(32) CF_STEP(16) CF_STEP(8) CF_STEP(4) CF_STEP(2) CF_STEP(1)
#undef CF_STEP
            if (lane == 0) {
#pragma unroll
                for (int tt = 0; tt < 32; ++tt) { part[(tt * 8 + wave) * 2] = s1[tt]; part[(tt * 8 + wave) * 2 + 1] = s2[tt]; } }
        }
        __syncthreads();
        if (tid < 32) { float s1 = 0.f, s2 = 0.f;
#pragma unroll
            for (int wv = 0; wv < 8; ++wv) { s1 += part[(tid * 8 + wv) * 2]; s2 += part[(tid * 8 + wv) * 2 + 1]; }
            const float mean = s1 * (1.f / C_W); const float var = fmaxf(s2 * (1.f / C_W) - mean * mean, 0.f);
            stat[tid * 2] = mean; stat[tid * 2 + 1] = rsqrtf(var + 1e-5f); }
        __syncthreads();
#pragma unroll
        for (int tt = 0; tt < 32; ++tt) { const float v = (yc[tt] - stat[tt * 2]) * stat[tt * 2 + 1] * lg + lb; CA[(size_t)(tok0 + tt) * C_W + tid] = (bf16_t)f2bf(v * sigmoidf_(v)); }
    }
}
__device__ __forceinline__ void phase_gates_b1(ArgsP a, const int tid, int layer, unsigned char* lds, int ngemm) {
    const int G = gridDim.x, blk = blockIdx.x;
    if (G >= ngemm + 64) {
        phase_gateprep(a, tid, layer, lds, blk - (G - 12));
        if (blk >= ngemm) for (int it = blk - ngemm; it < 512; it += G - ngemm) mlstm_b1_item(a, tid, layer, lds, it);
    } else {
        __syncthreads();
        phase_gateprep(a, tid, layer, lds, blk);
        for (int it = G - 1 - blk; it < 512; it += G) mlstm_b1_item(a, tid, layer, lds, it);
    }
}
__device__ __forceinline__ void phase_mixers(ArgsP a, const int tid, int layer, unsigned char* lds, int rep) {
    unsigned* head = (unsigned*)(a->ws + WS_CTL) + 8192 + 64 * (layer * 2 + rep);
    unsigned* slot = (unsigned*)(lds + MISC_OFF + 64);
    for (;;) {
        __syncthreads();
        if (tid == 0) *slot = atomicAdd(head, 1u);
        __syncthreads();
        int idx = (int)*slot;
        if (rep) idx += NSCAN;
        if (idx >= (rep ? NSCAN + ATT_ITEMS : NSCAN + ATT_ITEMS + NTOK / 32)) break;
        if (idx < NSCAN) mlstm_scan_piece(a, tid, lds, idx);
        else if (idx < NSCAN + ATT_ITEMS) attn_item(a, tid, layer, lds, (idx - NSCAN) % 12, 31 - (idx - NSCAN) / 12);
        else conv_front_tile(a, tid, layer, lds, idx - NSCAN - ATT_ITEMS);
    }
}
__device__ __forceinline__ void phase_mlstm_out(ArgsP a, const int tid, int layer, unsigned char* lds, int rep) {
    unsigned* head = (unsigned*)(a->ws + WS_CTL) + 8192 + 64 * (4 + layer * 2 + rep);
    unsigned* slot = (unsigned*)(lds + MISC_OFF + 64);
    for (;;) {
        __syncthreads();
        if (tid == 0) *slot = atomicAdd(head, 1u);
        __syncthreads();
        const int idx = (int)*slot;
        if (idx >= 512) break;
        mlstm_out_item(a, tid, layer, lds, idx);
    }
}

__device__ __forceinline__ void ycnorm_unit(ArgsP a, const int tid, int layer, int unit) {
    const int lane = tid & 63, wave = tid >> 6;
    pg8::StaticOrder S; S.init(NTOK, C_W, gridDim.x, unit); pg8::Unit u; if (!S.next(0, u)) return;
    const float* YC = (const float*)(a->ws + WS_YCR);
    bf16_t* Y = (bf16_t*)(a->ws + WS_Y);
    const float* ong = a->in[I_ONG] + layer * DM + 1536 + u.pn * 256;
    asm volatile("s_waitcnt vmcnt(0)" ::: "memory");
    __syncthreads();
    const f32x4 g = *(const f32x4*)(ong + lane * 4);
    for (int r0 = wave; r0 < 256; r0 += 64) {
        f32x4 v[8];
#pragma unroll
        for (int k = 0; k < 8; ++k) v[k] = *(const f32x4*)(YC + (size_t)(u.pm * 256 + r0 + 8 * k) * C_W + u.pn * 256 + lane * 4);
#pragma unroll
        for (int k = 0; k < 8; ++k) {
            const int tok = u.pm * 256 + r0 + 8 * k;
            float s = (v[k].x * v[k].x + v[k].y * v[k].y) + (v[k].z * v[k].z + v[k].w * v[k].w);
#pragma unroll
            for (int o = 16; o > 0; o >>= 1) s += SHX(s, o);
            const float r = rsqrtf(s * (1.f / 128.f) + 1e-6f);
            u32x2 w; w.x = pk2(v[k].x * r * g.x, v[k].y * r * g.y); w.y = pk2(v[k].z * r * g.z, v[k].w * r * g.w);
            *(u32x2*)(Y + (size_t)tok * DM + 1536 + u.pn * 256 + lane * 4) = w;
        }
    }
}
__device__ __forceinline__ float maxf3(float a, float b, float c) { return fmaxf(fmaxf(a, b), c); }
__device__ __forceinline__ unsigned fbits(float f) { return __builtin_bit_cast(unsigned, f); }
__device__ __forceinline__ float bitsf(unsigned u) { return __builtin_bit_cast(float, u); }
#define RT_CE(x_, y_) { const float hi_ = fmaxf(x_, y_), lo_ = fminf(x_, y_); x_ = hi_; y_ = lo_; }
#define RT_SORT_STEP(A_, k_, j_) _Pragma("unroll") for (int i_ = 0; i_ < 16; ++i_) { const int l_ = i_ ^ (j_); if (l_ > i_) { if ((i_ & (k_)) == 0) RT_CE(A_[i_], A_[l_]) else RT_CE(A_[l_], A_[i_]) } }
#define RT_SORT16(A_) RT_SORT_STEP(A_, 2, 1) RT_SORT_STEP(A_, 4, 2) RT_SORT_STEP(A_, 4, 1) RT_SORT_STEP(A_, 8, 4) RT_SORT_STEP(A_, 8, 2) RT_SORT_STEP(A_, 8, 1) RT_SORT_STEP(A_, 16, 8) RT_SORT_STEP(A_, 16, 4) RT_SORT_STEP(A_, 16, 2) RT_SORT_STEP(A_, 16, 1)
#define RT_BIT_STEP(A_, d_) _Pragma("unroll") for (int e_ = 0; e_ < 16; ++e_) if ((e_ & (d_)) == 0) RT_CE(A_[e_], A_[e_ + (d_)])
#define RT_MERGE16(O_, A_, B_) { _Pragma("unroll") for (int e_ = 0; e_ < 16; ++e_) O_[e_] = fmaxf(A_[e_], B_[15 - e_]); RT_BIT_STEP(O_, 8) RT_BIT_STEP(O_, 4) RT_BIT_STEP(O_, 2) RT_BIT_STEP(O_, 1) }
__device__ __forceinline__ void phase_peer_route(ArgsP a, const int tid, int layer, unsigned char* lds, const bool en) {
    const int lane = tid & 63, wave = __builtin_amdgcn_readfirstlane(tid >> 6);
    const int l31 = lane & 31, hh = lane >> 5;
    unsigned char* ws = a->ws;
    const float* Q = (const float*)(ws + WS_Q);
    const int h = blockIdx.x & 7, nb8 = gridDim.x >> 3;
    const bf16_t* KH = (const bf16_t*)(ws + WS_KH) + ((size_t)layer * P_H + h) * 2 * N_KEYS * 128;
    const bf16_t* KL = (const bf16_t*)(ws + WS_KL) + ((size_t)layer * P_H + h) * 2 * N_KEYS * 128;
    int* EI = (int*)(ws + WS_EIDX + layer * (8 * MiB)); float* EG = (float*)(ws + WS_EGATE + layer * (8 * MiB));
    unsigned char* myidx = lds + RT_TAB_OFF + 128 + ((wave & 3) * 64 + lane) * 32;
    const float NEG = -__builtin_inff();
    __syncthreads();
    { const int r4 = lane >> 4, p = lane & 15;
#pragma unroll
      for (int q = 0; q < 16; ++q) { const int seg = wave * 16 + q;
          const int blkq = seg >> 5, r = (seg & 31) * 4 + r4;
          const bf16_t* src = ((blkq & 1) ? KL : KH) + ((size_t)(blkq >> 1) * N_KEYS + r) * 128 + ((p ^ (r & 15)) << 3);
          __builtin_amdgcn_global_load_lds((const unsigned*)src, (LAS unsigned*)((LAS unsigned char*)lds + seg * 1024), 16, 0, 0); } }
    asm volatile("s_waitcnt vmcnt(0)" ::: "memory");
    __syncthreads();
    if (wave >= 4) return;
    const LAS unsigned char* kl0 = (const LAS unsigned char*)lds + l31 * 256;
    const int sw = l31 & 15;
    for (int tb = (blockIdx.x >> 3) * 4 + wave; tb < (en ? NTOK / 32 : 0); tb += nb8 * 4) {
        const int tok = tb * 32 + l31;
        const float* qrow = Q + (size_t)tok * DM + h * 256;
        float V[2][16];
#pragma unroll
        for (int c = 0; c < 2; ++c) {
            f32x4 xq[16];
#pragma unroll
            for (int p = 0; p < 16; ++p) xq[p] = *(const f32x4*)(qrow + c * 128 + 16 * (p >> 1) + 8 * hh + 4 * (p & 1));
            f32x16 acc[4];
#pragma unroll
            for (int t4 = 0; t4 < 4; ++t4)
#pragma unroll
                for (int r = 0; r < 16; ++r) acc[t4][r] = 0.f;
#pragma unroll
            for (int ks = 0; ks < 8; ++ks) {
                const f32x4 x0 = xq[2 * ks], x1 = xq[2 * ks + 1];
                u32x4 qhw, qlw;
                qhw.x = pk2(x0.x, x0.y); qhw.y = pk2(x0.z, x0.w); qhw.z = pk2(x1.x, x1.y); qhw.w = pk2(x1.z, x1.w);
                { const unsigned a0 = qhw.x, a1 = qhw.y, a2 = qhw.z, a3 = qhw.w;
                  qlw.x = pk2(x0.x - bf_lo(a0), x0.y - bf_hi(a0)); qlw.y = pk2(x0.z - bf_lo(a1), x0.w - bf_hi(a1)); qlw.z = pk2(x1.x - bf_lo(a2), x1.y - bf_hi(a2)); qlw.w = pk2(x1.z - bf_lo(a3), x1.w - bf_hi(a3)); }
                const bf16x8 qh = __builtin_bit_cast(bf16x8, qhw), ql = __builtin_bit_cast(bf16x8, qlw);
                const int pos = ((2 * ks + hh) ^ sw) << 4;
#pragma unroll
                for (int t4 = 0; t4 < 4; ++t4) {
                    const bf16x8 kh = *(const LAS bf16x8*)(kl0 + (c * 2) * 32768 + t4 * 8192 + pos), kl = *(const LAS bf16x8*)(kl0 + (c * 2 + 1) * 32768 + t4 * 8192 + pos);
                    acc[t4] = __builtin_amdgcn_mfma_f32_32x32x16_bf16(kh, qh, acc[t4], 0, 0, 0);
                    acc[t4] = __builtin_amdgcn_mfma_f32_32x32x16_bf16(kh, ql, acc[t4], 0, 0, 0);
                    acc[t4] = __builtin_amdgcn_mfma_f32_32x32x16_bf16(kl, qh, acc[t4], 0, 0, 0);
                }
            }
#pragma unroll
            for (int t4 = 0; t4 < 4; ++t4)
#pragma unroll
                for (int r = 0; r < 16; ++r) { const unsigned key = 32 * t4 + (r & 3) + 8 * (r >> 2) + 4 * hh;
                    const float av = acc[t4][r]; acc[t4][r] = bitsf((fbits(av) & 0xFFFFFF80u) | key); }
            float top[16];
            { float s0[16], s1[16], s2[16], s3[16], m01[16], m23[16];
#pragma unroll
              for (int r = 0; r < 16; ++r) { s0[r] = acc[0][r]; s1[r] = acc[1][r]; s2[r] = acc[2][r]; s3[r] = acc[3][r]; }
              RT_SORT16(s0) RT_SORT16(s1) RT_SORT16(s2) RT_SORT16(s3)
              RT_MERGE16(m01, s0, s1) RT_MERGE16(m23, s2, s3) RT_MERGE16(top, m01, m23) }
            float cm[16];
#pragma unroll
            for (int e = 0; e < 16; ++e) cm[e] = SHX(top[e], 32);
#pragma unroll
            for (int e = 0; e < 16; ++e) V[c][e] = fmaxf(top[e], cm[15 - e]);
#define BITONIC_STEP(d) _Pragma("unroll") for (int e = 0; e < 16; ++e) if ((e & (d)) == 0) { const float hi = fmaxf(V[c][e], V[c][e + (d)]), lo = fminf(V[c][e], V[c][e + (d)]); V[c][e] = hi; V[c][e + (d)] = lo; }
            BITONIC_STEP(8) BITONIC_STEP(4) BITONIC_STEP(2) BITONIC_STEP(1)
#undef BITONIC_STEP
#pragma unroll
            for (int e = 0; e < 16; ++e) myidx[c * 16 + e] = (unsigned char)(__builtin_bit_cast(unsigned, V[c][e]) & 127u);
        }
        float sel[16];
        { float c0[16], c1[16], c2[16], c3[16], m01[16], m23[16];
#pragma unroll
          for (int r = 0; r < 16; ++r) { c0[r] = NEG; c1[r] = NEG; c2[r] = NEG; c3[r] = NEG; }
          { int k = 0;
#pragma unroll
            for (int i = 0; i < 16; ++i)
#pragma unroll
              for (int j = 0; j < 16; ++j) if ((i + 1) * (j + 1) <= 16) {
                  const float s = __builtin_bit_cast(float, __builtin_bit_cast(unsigned, V[0][i]) & 0xFFFFFF80u) + __builtin_bit_cast(float, __builtin_bit_cast(unsigned, V[1][j]) & 0xFFFFFF80u);
                  const float cv = __builtin_bit_cast(float, (__builtin_bit_cast(unsigned, s) & 0xFFFFFF00u) | (unsigned)((i << 4) | j));
                  if (k < 16) c0[k & 15] = cv; else if (k < 32) c1[k & 15] = cv; else if (k < 48) c2[k & 15] = cv; else c3[k & 15] = cv;
                  ++k; } }
          RT_SORT16(c0) RT_SORT16(c1) RT_SORT16(c2) RT_SORT16(c3)
          RT_MERGE16(m01, c0, c1) RT_MERGE16(m23, c2, c3) RT_MERGE16(sel, m01, m23) }
        LDS_FENCE();
        const float mx = __builtin_bit_cast(float, __builtin_bit_cast(unsigned, sel[0]) & 0xFFFFFF00u);
        float ex[16], sum = 0.f; int eid[16];
#pragma unroll
        for (int e = 0; e < 16; ++e) { const unsigned bits = __builtin_bit_cast(unsigned, sel[e]);
            ex[e] = __expf(__builtin_bit_cast(float, bits & 0xFFFFFF00u) - mx); sum += ex[e];
            eid[e] = (int)myidx[(bits >> 4) & 15u] * N_KEYS + (int)myidx[16 + (bits & 15u)]; }
        const float inv = 1.f / sum;
        int* eo = EI + (size_t)tok * 128 + h * P_TOPK + 8 * hh; float* go = EG + (size_t)tok * 128 + h * P_TOPK + 8 * hh;
        if (hh == 0) {
#pragma unroll
            for (int e = 0; e < 8; ++e) { eo[e] = eid[e]; go[e] = ex[e] * inv; }
        } else {
#pragma unroll
            for (int e = 0; e < 8; ++e) { eo[e] = eid[8 + e]; go[e] = ex[8 + e] * inv; }
        }
        LDS_FENCE();
    }
}

constexpr size_t LSTRIDE = 116 * MiB;
constexpr size_t WS_PU = 576 * MiB;
constexpr size_t WS_PV = 608 * MiB;
constexpr size_t WS_PS = 640 * MiB;
constexpr size_t WS_XQ = 641 * MiB;
constexpr size_t WS_SX = 657 * MiB;
constexpr size_t WS_PA = 658 * MiB;
constexpr size_t WS_EGU = 434 * MiB;
constexpr size_t WS_SW = 690 * MiB + 512 * 1024;
constexpr size_t WS_EWQ = 691 * MiB;
constexpr size_t WS_SSQ = 690 * MiB;
constexpr int PEER_GRP = 256;
__device__ __forceinline__ int xsum16(int v) { const auto r = __builtin_amdgcn_permlane16_swap((unsigned)v, (unsigned)v, false, false); return (int)(r[0] + r[1]); }
__device__ __forceinline__ int xsum32(int v) { const auto r = __builtin_amdgcn_permlane32_swap((unsigned)v, (unsigned)v, false, false); return (int)(r[0] + r[1]); }
__device__ __forceinline__ float gelu_exact(float x) { return 0.5f * x * (1.f + erff(x * 0.70710678118654752f)); }
__device__ __forceinline__ float ub0(unsigned w) { return (float)(w & 0xffu); }
__device__ __forceinline__ float ub1(unsigned w) { return (float)((w >> 8) & 0xffu); }
__device__ __forceinline__ float ub2(unsigned w) { return (float)((w >> 16) & 0xffu); }
__device__ __forceinline__ float ub3(unsigned w) { return (float)(w >> 24); }
__device__ __forceinline__ unsigned q4(float a, float b, float c, float d, float inv, int bias) {
    const int qa = (int)rintf(a * inv) + bias, qb = (int)rintf(b * inv) + bias, qc = (int)rintf(c * inv) + bias, qd = (int)rintf(d * inv) + bias;
    return (unsigned)(qa & 0xff) | ((unsigned)(qb & 0xff) << 8) | ((unsigned)(qc & 0xff) << 16) | ((unsigned)(qd & 0xff) << 24);
}
__device__ __forceinline__ void peer_convert_tables(ArgsP a, int layer, const int tid) {
    const int lane = tid & 63, wave = (tid >> 6) - 4;
    const int gw = blockIdx.x * 4 + wave, NGW = gridDim.x * 4;
    unsigned char* ws = a->ws;
    float* PS = (float*)(ws + WS_PS + layer * LSTRIDE);
    if (gw >= 2 * N_EXP) return;
    f32x4 x[8];
    { const f32x4* src = (const f32x4*)(((gw & 1) ? a->in[I_PV] : a->in[I_PU]) + ((size_t)layer * N_EXP + (gw >> 1)) * DM);
#pragma unroll
      for (int j = 0; j < 2; ++j)
#pragma unroll
          for (int q = 0; q < 4; ++q) x[j * 4 + q] = src[4 * (lane + 64 * j) + q]; }
#pragma unroll 1
    for (int row = gw; row < 2 * N_EXP; row += NGW) {
        const int tb = row & 1, e = row >> 1;
        const int rn = row + NGW < 2 * N_EXP ? row + NGW : row;
        const f32x4* srcn = (const f32x4*)(((rn & 1) ? a->in[I_PV] : a->in[I_PU]) + ((size_t)layer * N_EXP + (rn >> 1)) * DM);
        f32x4 xn[8];
#pragma unroll
        for (int j = 0; j < 2; ++j)
#pragma unroll
            for (int q = 0; q < 4; ++q) xn[j * 4 + q] = srcn[4 * (lane + 64 * j) + q];
        float am = 0.f;
#pragma unroll
        for (int k = 0; k < 8; ++k) { const f32x4 v = x[k]; am = fmaxf(fmaxf(am, fmaxf(fabsf(v.x), fabsf(v.y))), fmaxf(fabsf(v.z), fabsf(v.w))); }
        am = wave_max(am, lane);
        const float inv = am > 0.f ? 127.f / am : 0.f;
        unsigned char* dstb = ws + (tb ? WS_PV : WS_PU) + layer * LSTRIDE;
        const int bias = 0;
#pragma unroll
        for (int j = 0; j < 2; ++j) { u32x4 w; const int idx = lane + 64 * j;
            w.x = q4(x[j * 4].x, x[j * 4].y, x[j * 4].z, x[j * 4].w, inv, bias); w.y = q4(x[j * 4 + 1].x, x[j * 4 + 1].y, x[j * 4 + 1].z, x[j * 4 + 1].w, inv, bias);
            w.z = q4(x[j * 4 + 2].x, x[j * 4 + 2].y, x[j * 4 + 2].z, x[j * 4 + 2].w, inv, bias); w.w = q4(x[j * 4 + 3].x, x[j * 4 + 3].y, x[j * 4 + 3].z, x[j * 4 + 3].w, inv, bias);
            *(u32x4*)(dstb + ((size_t)(idx >> 4) * N_EXP + e) * 256 + 16 * (idx & 15)) = w; }
        if (lane == 0) PS[tb * N_EXP + e] = am * (1.f / 127.f);
#pragma unroll
        for (int k = 0; k < 8; ++k) x[k] = xn[k];
    }
}
__device__ __forceinline__ void peer_quant_tokens(ArgsP a, int layer, const int tid) {
    const int lane = tid & 63, wave = (tid >> 6) - 4;
    const int gw = blockIdx.x * 4 + wave, NGW = gridDim.x * 4;
    unsigned char* ws = a->ws;
    const bf16_t* HN = (const bf16_t*)(ws + WS_HN);
    const float* P2 = (const float*)(ws + WS_P2);
    for (int t0 = gw; t0 < NTOK; t0 += 4 * NGW) {
        u32x4 hw[4][4]; float pp[4];
#pragma unroll
        for (int r = 0; r < 4; ++r) { const int tok = t0 + r * NGW; if (tok < NTOK) {
            pp[r] = P2[(size_t)(lane & 31) * NTOK + tok];
#pragma unroll
            for (int j = 0; j < 2; ++j)
#pragma unroll
                for (int q = 0; q < 2; ++q) hw[r][j * 2 + q] = ((const u32x4*)(HN + (size_t)tok * DM))[2 * (lane + 64 * j) + q]; } }
#pragma unroll
        for (int r = 0; r < 4; ++r) { const int tok = t0 + r * NGW; if (tok < NTOK) {
            float xf[32]; float am = 0.f;
#pragma unroll
            for (int c = 0; c < 4; ++c) { const u32x4 w = hw[r][c]; float* f = xf + c * 8;
                f[0] = bf_lo(w.x); f[1] = bf_hi(w.x); f[2] = bf_lo(w.y); f[3] = bf_hi(w.y); f[4] = bf_lo(w.z); f[5] = bf_hi(w.z); f[6] = bf_lo(w.w); f[7] = bf_hi(w.w); }
#pragma unroll
            for (int i = 0; i < 32; ++i) am = fmaxf(am, fabsf(xf[i]));
            am = wave_max(am, lane);
            const float rs = rsqrtf(wave_sum(lane < 32 ? pp[r] : 0.f, lane) * (1.f / DM) + 1e-6f);
            const float inv = am > 0.f ? 127.f / am : 0.f;
#pragma unroll
            for (int j = 0; j < 2; ++j) { u32x4 w; const float* f = xf + 16 * j;
                w.x = q4(f[0], f[1], f[2], f[3], inv, 0); w.y = q4(f[4], f[5], f[6], f[7], inv, 0); w.z = q4(f[8], f[9], f[10], f[11], inv, 0); w.w = q4(f[12], f[13], f[14], f[15], inv, 0);
                ((u32x4*)(ws + WS_XQ + layer * LSTRIDE + (size_t)tok * DM))[lane + 64 * j] = w; }
            if (lane == 0) ((float*)(ws + WS_SX + layer * LSTRIDE))[tok] = am * rs * (1.f / 127.f); } }
    }
}
__device__ __forceinline__ bool peer_pull(unsigned* heads, unsigned* slot, const int tid, int& cur, const int mine, int& slice, int& grp) {
    constexpr unsigned LIM = (unsigned)(NTOK / PEER_GRP);
    for (;;) {
        if (cur >= 8) return false;
        __syncthreads();
        if (tid < 64) {
            const unsigned hv = (tid < 8) ? xb_ld(heads + 64 * ((mine + tid) & 7)) : ~0u;
            const unsigned long long m = __builtin_amdgcn_ballot_w64(tid >= cur && tid < 8 && hv < LIM);
            if (tid == 0) {
                if (m == 0ull) { slot[0] = ~0u; slot[1] = 8u; }
                else { const int c = __builtin_ctzll(m); slot[0] = atomicAdd(heads + 64 * ((mine + c) & 7), 1u); slot[1] = (unsigned)c; }
            }
        }
        __syncthreads();
        const unsigned idx = slot[0]; const int c = (int)slot[1];
        if (c >= 8) { cur = 8; return false; }
        if (idx < LIM) { cur = c; slice = (mine + c) & 7; grp = (int)idx; return true; }
        cur = c + 1;
    }
}
__device__ __forceinline__ void phase_peer_u(ArgsP a, const int tid, int layer, unsigned char* lds, int rep) {
    const int lane = tid & 63, wave = __builtin_amdgcn_readfirstlane(tid >> 6);
    const int g = lane >> 4, i = lane & 15;
    unsigned char* ws = a->ws;
    unsigned* heads = (unsigned*)(ws + WS_CTL) + 8192 + 64 * (8 + 16 * layer + 32 * rep);
    unsigned* slot = (unsigned*)(lds + MISC_OFF + 64);
    int* idsb = (int*)lds + wave * 256;
    const int* EI = (const int*)(ws + WS_EIDX + layer * (8 * MiB));
    const bool b3 = i & 8, b2 = i & 4, b1 = i & 2, b0 = i & 1;
    int cur = 0, slice, grp; const int mine = (int)xb_xcc_id() & 7;
#define PU_LOADH(buf, idp, h) do { _Pragma("unroll") for (int k_ = 0; k_ < 16; ++k_) buf[k_] = *(const u32x4*)(UTs + ((unsigned)(idp)[32 * g + 16 * (h) + k_] + i16u)); } while (0)
#define PU_REDH(buf, xq_, out_) do { int d_[16]; _Pragma("unroll") for (int k_ = 0; k_ < 16; ++k_) { const u32x4 w_ = buf[k_]; \
            int c_ = __builtin_amdgcn_sdot4((int)w_.x, (int)(xq_).x, 0, false); c_ = __builtin_amdgcn_sdot4((int)w_.y, (int)(xq_).y, c_, false); c_ = __builtin_amdgcn_sdot4((int)w_.z, (int)(xq_).z, c_, false); d_[k_] = __builtin_amdgcn_sdot4((int)w_.w, (int)(xq_).w, c_, false); } \
        int v8_[8], v4_[4], v2_[2]; \
        _Pragma("unroll") for (int k_ = 0; k_ < 8; ++k_) { const int keep_ = b3 ? d_[k_ + 8] : d_[k_], send_ = b3 ? d_[k_] : d_[k_ + 8]; v8_[k_] = keep_ + __builtin_amdgcn_update_dpp(0, send_, 0x128, 0xf, 0xf, false); } \
        _Pragma("unroll") for (int k_ = 0; k_ < 4; ++k_) { const int keep_ = b2 ? v8_[k_ + 4] : v8_[k_], send_ = b2 ? v8_[k_] : v8_[k_ + 4]; v4_[k_] = keep_ + __builtin_amdgcn_update_dpp(__builtin_amdgcn_update_dpp(0, send_, 0x104, 0xf, 0x5, false), send_, 0x114, 0xf, 0xa, false); } \
        _Pragma("unroll") for (int k_ = 0; k_ < 2; ++k_) { const int keep_ = b1 ? v4_[k_ + 2] : v4_[k_], send_ = b1 ? v4_[k_] : v4_[k_ + 2]; v2_[k_] = keep_ + __builtin_amdgcn_update_dpp(0, send_, 0x4E, 0xf, 0xf, false); } \
        const int keep1_ = b0 ? v2_[1] : v2_[0], send1_ = b0 ? v2_[0] : v2_[1]; out_ = keep1_ + __builtin_amdgcn_update_dpp(0, send1_, 0xB1, 0xf, 0xf, false); } while (0)
    while (peer_pull(heads, slot, tid, cur, mine, slice, grp)) {
        const unsigned char* UTs = ws + WS_PU + layer * LSTRIDE + (size_t)__builtin_amdgcn_readfirstlane(slice) * N_EXP * 256; const unsigned i16u = 16u * (unsigned)i;
        int* PA = (int*)(ws + WS_PA + layer * LSTRIDE) + (size_t)slice * NTOK * 128;
        const int tok0 = grp * PEER_GRP + wave * (PEER_GRP / 8);
        const unsigned char* xqp = ws + WS_XQ + layer * LSTRIDE + (size_t)tok0 * DM + 256 * slice + 16 * i;
        u32x4 bA[16], bB[16];
        u32x4 xq = *(const u32x4*)xqp, xqn = xq; int e0n = 0, e1n = 0;
        idsb[lane] = EI[(size_t)tok0 * 128 + lane] << 8; idsb[64 + lane] = EI[(size_t)tok0 * 128 + 64 + lane] << 8;
        LDS_FENCE();
        PU_LOADH(bA, idsb, 0);
#pragma unroll 1
        for (int tt = 0; tt < PEER_GRP / 8; ++tt) {
            const int tok = tok0 + tt; const bool more = tt + 1 < PEER_GRP / 8;
            int* idc = idsb + (tt & 1) * 128; int* idn = idsb + ((tt + 1) & 1) * 128;
            if (more) { e0n = EI[(size_t)(tok + 1) * 128 + lane]; e1n = EI[(size_t)(tok + 1) * 128 + 64 + lane]; xqn = *(const u32x4*)(xqp + (size_t)(tt + 1) * DM); }
            PU_LOADH(bB, idc, 1);
            int r0, r1;
            PU_REDH(bA, xq, r0);
            if (more) { idn[lane] = e0n << 8; idn[64 + lane] = e1n << 8; LDS_FENCE(); PU_LOADH(bA, idn, 0); }
            PU_REDH(bB, xq, r1);
            PA[(size_t)tok * 128 + 32 * g + i] = r0; PA[(size_t)tok * 128 + 32 * g + 16 + i] = r1;
            xq = xqn;
        }
        LDS_FENCE();
    }
#undef PU_LOADH
#undef PU_REDH
}
__device__ __forceinline__ void phase_peer_a(ArgsP a, const int tid, int layer, unsigned char* lds) {
    const int lane = tid & 63, wave = tid >> 6;
    const int gw = blockIdx.x * 8 + wave, NGW = gridDim.x * 8;
    unsigned char* ws = a->ws;
    const float* EG = (const float*)(ws + WS_EGATE + layer * (8 * MiB)); const int* EI = (const int*)(ws + WS_EIDX + layer * (8 * MiB));
    const float* SU = (const float*)(ws + WS_PS + layer * LSTRIDE); const float* SV = SU + N_EXP;
    const float* SX = (const float*)(ws + WS_SX + layer * LSTRIDE); const int* PA = (const int*)(ws + WS_PA + layer * LSTRIDE);
    unsigned* WQ = (unsigned*)(ws + WS_EWQ + layer * LSTRIDE); float* SW = (float*)(ws + WS_SW + layer * LSTRIDE);
    unsigned char* wb = lds + wave * 128;
    for (int t0 = gw; t0 < NTOK; t0 += 4 * NGW) {
        int pa0[4][8], pa1[4][8], e0[4], e1[4]; float g0[4], g1[4], sx[4];
#pragma unroll
        for (int r = 0; r < 4; ++r) { const int tok = t0 + r * NGW; if (tok < NTOK) {
            e0[r] = EI[(size_t)tok * 128 + lane]; e1[r] = EI[(size_t)tok * 128 + 64 + lane]; g0[r] = EG[(size_t)tok * 128 + lane]; g1[r] = EG[(size_t)tok * 128 + 64 + lane]; sx[r] = SX[tok];
#pragma unroll
            for (int s = 0; s < 8; ++s) { pa0[r][s] = PA[((size_t)s * NTOK + tok) * 128 + lane]; pa1[r][s] = PA[((size_t)s * NTOK + tok) * 128 + 64 + lane]; } } }
        float su0[4], su1[4], sv0[4], sv1[4];
#pragma unroll
        for (int r = 0; r < 4; ++r) { const int tok = t0 + r * NGW; if (tok < NTOK) { su0[r] = SU[e0[r]]; su1[r] = SU[e1[r]]; sv0[r] = SV[e0[r]]; sv1[r] = SV[e1[r]]; } }
#pragma unroll
        for (int r = 0; r < 4; ++r) { const int tok = t0 + r * NGW; if (tok < NTOK) {
            int p0 = 0, p1 = 0;
#pragma unroll
            for (int s = 0; s < 8; ++s) { p0 += pa0[r][s]; p1 += pa1[r][s]; }
            const float w0 = gelu_exact((float)p0 * su0[r] * sx[r]) * g0[r] * sv0[r];
            const float w1 = gelu_exact((float)p1 * su1[r] * sx[r]) * g1[r] * sv1[r];
            const float am = wave_max(fmaxf(fabsf(w0), fabsf(w1)), lane);
            const float inv = am > 0.f ? 127.f / am : 0.f;
            wb[lane] = (unsigned char)((int)rintf(w0 * inv) & 0xff); wb[64 + lane] = (unsigned char)((int)rintf(w1 * inv) & 0xff);
            LDS_FENCE();
            if (lane < 32) WQ[(size_t)tok * 32 + lane] = ((const unsigned*)wb)[lane];
            if (lane == 0) SW[tok] = am * (1.f / 127.f);
            LDS_FENCE(); } }
    }
}
__device__ __forceinline__ void phase_peer_v(ArgsP a, const int tid, int layer, unsigned char* lds) {
    const int lane = tid & 63, wave = __builtin_amdgcn_readfirstlane(tid >> 6);
    const int g = lane >> 4, i = lane & 15;
    unsigned char* ws = a->ws;
    unsigned* heads = (unsigned*)(ws + WS_CTL) + 8192 + 64 * (16 + 16 * layer);
    unsigned* slot = (unsigned*)(lds + MISC_OFF + 64);
    int* idsb = (int*)lds + wave * 512;
    const int* EI = (const int*)(ws + WS_EIDX + layer * (8 * MiB));
    const unsigned* WQ = (const unsigned*)(ws + WS_EWQ + layer * LSTRIDE); const float* SW = (const float*)(ws + WS_SW + layer * LSTRIDE);
    float* X = (float*)(ws + WS_X);
    float* SSQ = (float*)(ws + WS_SSQ + layer * LSTRIDE);
    bf16_t* HNo = (bf16_t*)(ws + WS_HN);
    int cur = 0, slice, grp; const int mine = (int)xb_xcc_id() & 7;
    constexpr int NT = PEER_GRP / 8;
    unsigned i16v = 16u * (unsigned)i;
#define PV_PIN() asm volatile("" : "+v"(i16v) : "v"(acc[0]), "v"(acc[1]), "v"(acc[2]), "v"(acc[3]), "v"(acc[4]), "v"(acc[5]), "v"(acc[6]), "v"(acc[7]), "v"(acc[8]), "v"(acc[9]), "v"(acc[10]), "v"(acc[11]), "v"(acc[12]), "v"(acc[13]), "v"(acc[14]), "v"(acc[15]) : "memory")
#define PV_ISSUE(q_, idp_) do { _Pragma("unroll") for (int b_ = 0; b_ < 8; ++b_) { const unsigned off_ = (unsigned)(idp_)[32 * g + 8 * (q_) + b_] + i16v; vall[8 * (q_) + b_] = *(const u32x4*)(VTs + off_); } } while (0)
#define PV_Q(q_, A_, B_, C_, D_) do { const unsigned x0_ = __builtin_amdgcn_perm(B_, A_, 0x05010400u), x1_ = __builtin_amdgcn_perm(B_, A_, 0x07030602u), y0_ = __builtin_amdgcn_perm(D_, C_, 0x05010400u), y1_ = __builtin_amdgcn_perm(D_, C_, 0x07030602u); \
                        acc[4 * (q_) + 0] = __builtin_amdgcn_sdot4((int)__builtin_amdgcn_perm(y0_, x0_, 0x05040100u), wq_, acc[4 * (q_) + 0], false); \
                        acc[4 * (q_) + 1] = __builtin_amdgcn_sdot4((int)__builtin_amdgcn_perm(y0_, x0_, 0x07060302u), wq_, acc[4 * (q_) + 1], false); \
                        acc[4 * (q_) + 2] = __builtin_amdgcn_sdot4((int)__builtin_amdgcn_perm(y1_, x1_, 0x05040100u), wq_, acc[4 * (q_) + 2], false); \
                        acc[4 * (q_) + 3] = __builtin_amdgcn_sdot4((int)__builtin_amdgcn_perm(y1_, x1_, 0x07060302u), wq_, acc[4 * (q_) + 3], false); } while (0)
#define PV_COMP(q_, wp_) do { _Pragma("unroll") for (int m_ = 0; m_ < 2; ++m_) { const int wq_ = (int)(wp_)[8 * g + 2 * (q_) + m_]; \
                        const u32x4 ra = vall[8 * (q_) + 4 * m_], rb = vall[8 * (q_) + 4 * m_ + 1], rc = vall[8 * (q_) + 4 * m_ + 2], rd = vall[8 * (q_) + 4 * m_ + 3]; \
                        PV_Q(0, ra.x, rb.x, rc.x, rd.x); PV_Q(1, ra.y, rb.y, rc.y, rd.y); PV_Q(2, ra.z, rb.z, rc.z, rd.z); PV_Q(3, ra.w, rb.w, rc.w, rd.w); } } while (0)
#define PV_TOKEN(MORE_) do { \
            const int tok = tok0 + tt; \
            int* idn = idsb + ((tt + 1) & 1) * 128; const unsigned* wqc = (const unsigned*)(idsb + 256 + (tt & 1) * 32); \
            const float swnx = swn; \
            if (MORE_) { idn[lane] = e0n << 8; idn[64 + lane] = e1n << 8; if (lane < 32) ((unsigned*)(idsb + 256 + ((tt + 1) & 1) * 32))[lane] = wqn; LDS_FENCE(); \
                if (tt + 2 < NT) { e0n = EI[(size_t)(tok + 2) * 128 + lane]; e1n = EI[(size_t)(tok + 2) * 128 + 64 + lane]; wqn = (lane < 32) ? WQ[(size_t)(tok + 2) * 32 + lane] : 0u; swn = SW[tok + 2]; } } \
            int acc[16]; \
            _Pragma("unroll") for (int c = 0; c < 16; ++c) acc[c] = 0; \
            PV_COMP(0, wqc); PV_PIN(); if (MORE_) PV_ISSUE(0, idn); asm volatile("" ::: "memory"); \
            PV_COMP(1, wqc); PV_PIN(); if (MORE_) PV_ISSUE(1, idn); asm volatile("" ::: "memory"); \
            PV_COMP(2, wqc); PV_PIN(); if (MORE_) PV_ISSUE(2, idn); asm volatile("" ::: "memory"); \
            PV_COMP(3, wqc); PV_PIN(); if (MORE_) PV_ISSUE(3, idn); asm volatile("" ::: "memory"); \
              \
              \
            int r8[8], t4[4]; \
            _Pragma("unroll") for (int c = 0; c < 8; ++c) { const auto s_ = __builtin_amdgcn_permlane32_swap((unsigned)acc[c], (unsigned)acc[c + 8], false, false); r8[c] = (int)(s_[0] + s_[1]); } \
            _Pragma("unroll") for (int c = 0; c < 4; ++c) { const auto s_ = __builtin_amdgcn_permlane16_swap((unsigned)r8[c], (unsigned)r8[c + 4], false, false); t4[c] = (int)(s_[0] + s_[1]); } \
            const int t0 = t4[0], t1 = t4[1], t2 = t4[2], t3 = t4[3]; \
            f32x4* xp = (f32x4*)(X + (size_t)tok * DM + 256 * slice + 16 * i + 4 * g); \
            f32x4 v = xo1; v.x += sw * (float)t0; v.y += sw * (float)t1; v.z += sw * (float)t2; v.w += sw * (float)t3; *xp = v; \
            float ss = (v.x * v.x + v.y * v.y) + (v.z * v.z + v.w * v.w); \
            if (layer == 0) { u32x2 w; w.x = pk2(v.x * gn1.x, v.y * gn1.y); w.y = pk2(v.z * gn1.z, v.w * gn1.w); *(u32x2*)(HNo + (size_t)tok * DM + 256 * slice + 16 * i + 4 * g) = w; } \
            ss = rowsum16_dpp(ss); { const auto q_ = __builtin_amdgcn_permlane16_swap(__builtin_bit_cast(unsigned, ss), __builtin_bit_cast(unsigned, ss), false, false); ss = __builtin_bit_cast(float, (unsigned)q_[0]) + __builtin_bit_cast(float, (unsigned)q_[1]); } \
            { const auto r_ = __builtin_amdgcn_permlane32_swap(__builtin_bit_cast(unsigned, ss), __builtin_bit_cast(unsigned, ss), false, false); ss = __builtin_bit_cast(float, (unsigned)r_[0]) + __builtin_bit_cast(float, (unsigned)r_[1]); } \
            if (lane == 15) SSQ[(size_t)slice * NTOK + tok] = ss; \
            if (MORE_) xo1 = xp[DM / 4]; \
            sw = swnx; } while (0)
    while (peer_pull(heads, slot, tid, cur, mine, slice, grp)) {
        const unsigned char* VTs = ws + WS_PV + layer * LSTRIDE + (size_t)__builtin_amdgcn_readfirstlane(slice) * N_EXP * 256;
        const int tok0 = grp * PEER_GRP + wave * NT;
        idsb[lane] = EI[(size_t)tok0 * 128 + lane] << 8; idsb[64 + lane] = EI[(size_t)tok0 * 128 + 64 + lane] << 8; if (lane < 32) ((unsigned*)(idsb + 256))[lane] = WQ[(size_t)tok0 * 32 + lane];
        float sw = SW[tok0];
        int e0n = EI[(size_t)(tok0 + 1) * 128 + lane], e1n = EI[(size_t)(tok0 + 1) * 128 + 64 + lane]; unsigned wqn = (lane < 32) ? WQ[(size_t)(tok0 + 1) * 32 + lane] : 0u; float swn = SW[tok0 + 1];
        LDS_FENCE();
        u32x4 vall[32];
        PV_ISSUE(0, idsb); PV_ISSUE(1, idsb); PV_ISSUE(2, idsb); PV_ISSUE(3, idsb);
        f32x4 xo1;
        const f32x4 gn1 = *(const f32x4*)(a->in[I_N1G] + DM + 256 * slice + 16 * i + 4 * g);
        xo1 = *(const f32x4*)(X + (size_t)tok0 * DM + 256 * slice + 16 * i + 4 * g);
        int tt = 0;
#pragma unroll 1
        for (; tt < NT - 1; ++tt) PV_TOKEN(1);
        PV_TOKEN(0);
        LDS_FENCE();
    }
#undef PV_ISSUE
#undef PV_Q
#undef PV_COMP
#undef PV_TOKEN
#undef PV_PIN
}
__device__ __forceinline__ void phase_peer_norm(ArgsP a, const int tid, int layer) {
    const int lane = tid & 63, wave = tid >> 6;
    const int gw = blockIdx.x * 8 + wave, NGW = gridDim.x * 8;
    unsigned char* ws = a->ws;
    const float* X = (const float*)(ws + WS_X);
    const float* SSQ = (const float*)(ws + WS_SSQ + layer * LSTRIDE);
    const f32x4* g = (const f32x4*)a->in[I_FING];
    f32x4 gv[8];
#pragma unroll
    for (int j = 0; j < 8; ++j) gv[j] = g[lane + 64 * j];
    for (int t0 = gw; t0 < NTOK; t0 += 4 * NGW) {
        f32x4 v[4][8]; float sq[4];
#pragma unroll
        for (int r = 0; r < 4; ++r) { const int tok = t0 + r * NGW; sq[r] = 0.f; if (tok < NTOK) {
            sq[r] = SSQ[(size_t)(lane & 7) * NTOK + tok];
#pragma unroll
            for (int j = 0; j < 8; ++j) v[r][j] = ((const f32x4*)(X + (size_t)tok * DM))[lane + 64 * j]; } }
#pragma unroll
        for (int r = 0; r < 4; ++r) { const int tok = t0 + r * NGW; if (tok < NTOK) {
            float sqs = sq[r]; sqs += SHX(sqs, 1); sqs += SHX(sqs, 2); sqs += SHX(sqs, 4);
            const float rs = rsqrtf(sqs * (1.f / DM) + 1e-6f);
            { f32x4* o = (f32x4*)(a->out + (size_t)tok * DM);
#pragma unroll
                for (int j = 0; j < 8; ++j) o[lane + 64 * j] = v[r][j] * rs * gv[j]; } } }
    }
}
#ifndef EN_MASK
#define EN_MASK 8191
#endif
#ifndef PROBE7
#define PROBE7 0
#endif
#ifndef REP_MASK
#define REP_MASK 0
#endif
__global__ void __launch_bounds__(512, 2) hybrid_fwd(Args args) {
    extern __shared__ __attribute__((aligned(16))) unsigned char lds[];
    const int G = gridDim.x;
    volatile LAS unsigned* MISC = (volatile LAS unsigned*)((LAS unsigned char*)lds + MISC_OFF);
    const int wave_s = __builtin_amdgcn_readfirstlane((int)threadIdx.x >> 6);
#define CUR_TID() (wave_s * 64 + lane_now())
    for (int u = threadIdx.x; u < (LDS_BYTES - MISC_OFF) / 4; u += 512) MISC[u] = 0u;
    __syncthreads();
    const int ph_lo = args.ph_lo, ph_hi = args.ph_hi;
    const bool multi = (ph_hi - ph_lo) > 1;
    XcdBarrier bar; bar.bar = (unsigned*)(args.ws + WS_CTL); bar.x = 0; bar.st = nullptr;
    if (multi) bar = xcd_barrier_post((unsigned*)(args.ws + WS_CTL), MISC + 8, CUR_TID());
    LAS unsigned char* ldsp = (LAS unsigned char*)lds;
    for (int ph = ph_lo; ph < ph_hi; ++ph) {
        if (ph == NSUB) continue;
        ArgsP a = (ArgsP)__builtin_amdgcn_kernarg_segment_ptr(); asm volatile("" : "+s"(a));
        int tid = CUR_TID(); asm volatile("" : "+v"(tid));
        const int sub_ = (ph == 0) ? 15 : (ph - 1) % NSUB;
        const int nrep = ((REP_MASK >> sub_) & 1) ? 2 : 1;
        for (int rep = 0; rep < nrep; ++rep) {
        if (rep) xcd_barrier(bar, tid);
        if (ph == 0) { if (EN_MASK & 1024) { int tq = tid; asm volatile("" : "+v"(tq)); phase_prologue(a, tq, lds); } }
        else {
            const int layer = (ph - 1) / NSUB, sub = (ph - 1) % NSUB;
            unsigned char* ws = a->ws;
            switch (sub) {
            case 0: if (EN_MASK & 1) { int tq = tid; asm volatile("" : "+v"(tq));
                      pg8::Gemm g{(const bf16_t*)(ws + WS_HN), (const bf16_t*)(ws + WS_WIN) + (size_t)layer * ZLD * DM, NTOK, ZC_CG, DM};
                      RsOrder S; S.S.init(NTOK, ZC_CG, G, (int)blockIdx.x); S.P = (const float*)(ws + WS_SSQ); S.np = layer ? 8 : 0; S.rsb = (LAS float*)(ldsp + RS_OFF); S.wave_s = wave_s; S.k = 0;
                      EpiZ E{(bf16_t*)(ws + WS_Z), (float*)(ws + WS_GATE), 0, ZC_GT / 256, (const LAS float*)(ldsp + RS_OFF), 0}; pg8::gemm_phase<EpiZ, RsOrder, true, true>(tq, ldsp, g, S, E); } break;
            case 1: if (EN_MASK & 2) { int tq = tid; asm volatile("" : "+v"(tq));
                      pg8::Gemm g{(const bf16_t*)(ws + WS_HN), (const bf16_t*)(ws + WS_WIN) + ((size_t)layer * ZLD + ZC_CG) * DM, NTOK, ZLD - ZC_CG, DM};
                      RsOrder S; S.S.init(NTOK, ZLD - ZC_CG, G, (int)blockIdx.x); S.P = (const float*)(ws + WS_SSQ); S.np = layer ? 8 : 0; S.rsb = (LAS float*)(ldsp + RS_OFF); S.wave_s = wave_s; S.k = 0;
                      EpiZ E{(bf16_t*)(ws + WS_Z), (float*)(ws + WS_GATE), ZC_CG, -1, (const LAS float*)(ldsp + RS_OFF), 0}; pg8::gemm_phase<EpiZ, RsOrder, true, true>(tq, ldsp, g, S, E);
                      phase_gates_b1(a, tq, layer, lds, S.S.nwg); } break;
            case 2: if (EN_MASK & 4) { int tq = tid; asm volatile("" : "+v"(tq)); phase_mixers(a, tq, layer, lds, rep); } break;
            case 3: if (EN_MASK & 8) { int tq = tid; asm volatile("" : "+v"(tq));  pg8::Gemm g{(const bf16_t*)(ws + WS_CACT), (const bf16_t*)(ws + WS_WPW) + (size_t)layer * C_W * C_W, NTOK, C_W, C_W}; pg8::StaticOrder S; S.init(NTOK, C_W, G, (int)blockIdx.x);
                      EpiF32 E{(float*)(ws + WS_YCR), C_W, a->in[I_CPWB] + layer * C_W}; pg8::gemm_phase<EpiF32, pg8::StaticOrder, true, true>(tq, ldsp, g, S, E); ycnorm_unit(a, tq, layer, (int)blockIdx.x); phase_mlstm_out(a, tq, layer, lds, rep); } break;
            case 4: if (EN_MASK & 32) { int tq = tid; asm volatile("" : "+v"(tq));  pg8::Gemm g{(const bf16_t*)(ws + WS_Y), (const bf16_t*)(ws + WS_WOUT) + (size_t)layer * DM * DM, NTOK, DM, DM}; pg8::StaticOrder S; S.init(NTOK, DM, G, (int)blockIdx.x);
                      EpiResidN E{layer == 0 ? a->in[I_X] : (const float*)(ws + WS_X), (float*)(ws + WS_X), (bf16_t*)(ws + WS_HN), a->in[I_N2G] + layer * DM, (float*)(ws + WS_P2)};
                      pg8::gemm_phase<EpiResidN, pg8::StaticOrder, true, true>(tq, ldsp, g, S, E); } break;
            case 5: if (EN_MASK & 128) { int tq = tid; asm volatile("" : "+v"(tq));  pg8::Gemm g{(const bf16_t*)(ws + WS_HN), (const bf16_t*)(ws + WS_WQ) + (size_t)layer * DM * DM, NTOK, DM, DM};
                      RsOrder S; S.S.init(NTOK, DM, G, (int)blockIdx.x); S.P = (const float*)(ws + WS_P2); S.np = 32; S.rsb = (LAS float*)(ldsp + RS_OFF); S.wave_s = wave_s; S.k = 0;
                      EpiF32R E{(float*)(ws + WS_Q), DM, (const LAS float*)(ldsp + RS_OFF), 0}; pg8::gemm_phase<EpiF32R, RsOrder, true, true>(tq, ldsp, g, S, E); } break;
            case 6: if (EN_MASK & 256) { int tq = tid; asm volatile("" : "+v"(tq)); phase_peer_route(a, tq, layer, lds, true); if (__builtin_amdgcn_readfirstlane(tq >> 6) >= 4) { __builtin_amdgcn_s_setprio(1); peer_convert_tables(a, layer, tq); peer_quant_tokens(a, layer, tq); __builtin_amdgcn_s_setprio(0); } } break;
            case 7: if (EN_MASK & 512) { int tq = tid; asm volatile("" : "+v"(tq)); phase_peer_u(a, tq, layer, lds, rep); } break;
            case 8: if (EN_MASK & 512) { int tq = tid; asm volatile("" : "+v"(tq)); phase_peer_a(a, tq, layer, lds); } break;
            case 9: if (EN_MASK & 2048) { int tq = tid; asm volatile("" : "+v"(tq)); phase_peer_v(a, tq, layer, lds); } break;
            default: if (EN_MASK & 4096) { int tq = tid; asm volatile("" : "+v"(tq)); phase_peer_norm(a, tq, layer); } break;
            }
        }
        }
        if (ph + 1 < ph_hi) xcd_barrier(bar, CUR_TID());
    }
}

extern "C" void kernel_launch(void* const* d_in, const int* in_sizes, int n_in, void* d_out, int out_size, void* d_ws, size_t ws_size, hipStream_t stream) {
    static int grid = 0;
    if (grid == 0) {
        if (n_in != 21 || in_sizes[0] != NTOK * DM || out_size != NTOK * DM || ws_size < WS_END) { fprintf(stderr, "kernel_launch: unexpected shapes (n_in %d, in0 %d, out %d, ws %zu)\n", n_in, n_in > 0 ? in_sizes[0] : -1, out_size, ws_size); grid = -1; return; }
        int dev = 0, cus = 0;
        if (hipGetDevice(&dev) != hipSuccess || hipDeviceGetAttribute(&cus, hipDeviceAttributeMultiprocessorCount, dev) != hipSuccess) { grid = -1; return; }
        if (hipFuncSetAttribute((const void*)hybrid_fwd, hipFuncAttributeMaxDynamicSharedMemorySize, LDS_BYTES) != hipSuccess) { fprintf(stderr, "kernel_launch: hipFuncSetAttribute failed\n"); grid = -1; return; }
        (void)hipGetLastError();
        if (cus < 192) { fprintf(stderr, "kernel_launch: needs at least 192 CUs (row-scale slots), got %d\n", cus); grid = -1; return; }
        grid = cus;
    }
    if (grid < 0) return;
    (void)hipMemsetAsync((char*)d_ws + WS_CTL, 0, CTL_ZERO_BYTES, stream);
    Args a{};
    for (int i = 0; i < 21; ++i) a.in[i] = (const float*)d_in[i];
    a.out = (float*)d_out; a.ws = (unsigned char*)d_ws;
#if MK_ONE_LAUNCH
    a.ph_lo = 0; a.ph_hi = NPHASE;
    hipLaunchKernelGGL(hybrid_fwd, dim3(grid), dim3(512), LDS_BYTES, stream, a);
#else
    for (int ph = 0; ph < NPHASE; ++ph) { a.ph_lo = ph; a.ph_hi = ph + 1; hipLaunchKernelGGL(hybrid_fwd, dim3(grid), dim3(512), LDS_BYTES, stream, a); }
#endif
}
```
